# Optimizing an MI355X kernel written in HIP

```python
import math
import jax
import jax.numpy as jnp
from jax import lax
import numpy as np

D_MODEL = 1024
BATCH = 8
SEQ = 2048
DEPTH = 2

CTX_LEN = 256
GRID_W = 64
EPS = 1e-6
N_MOD = 6
HEAD_DIM = 64
ATTN_WIDTH = D_MODEL // 2
N_HEADS = ATTN_WIDTH // HEAD_DIM
N_KV_HEADS = 2
Q_PER_KV = N_HEADS // N_KV_HEADS
ROPE_THETA = 10000.0
ATTN_BLOCK = 128
SSD_WIDTH = D_MODEL - ATTN_WIDTH
SSD_HEAD_DIM = 64
SSD_HEADS = SSD_WIDTH // SSD_HEAD_DIM
SSD_GROUPS = 2
HEADS_PER_GROUP = SSD_HEADS // SSD_GROUPS
D_STATE = 128
CONV_WIDTH = 5
SSD_CHUNK = 128
D_FF = -(-8 * D_MODEL // (3 * 256)) * 256
Q_DIM = N_HEADS * HEAD_DIM
KV_DIM = N_KV_HEADS * HEAD_DIM
BC_DIM = SSD_GROUPS * D_STATE
XBC_DIM = SSD_WIDTH + 2 * BC_DIM
IN_DIM = Q_DIM + 2 * KV_DIM + SSD_WIDTH + XBC_DIM + SSD_HEADS
IN_SPLITS = (Q_DIM, Q_DIM + KV_DIM, Q_DIM + 2 * KV_DIM, Q_DIM + 2 * KV_DIM + SSD_WIDTH,
             Q_DIM + 2 * KV_DIM + SSD_WIDTH + XBC_DIM)

kernel_name = 'hybrid_attn_ssd_dit_trunk'


def rmsnorm(x, w):
    xf = x.astype(jnp.float32)
    y = xf * lax.rsqrt(jnp.mean(xf * xf, axis=-1, keepdims=True) + EPS)
    return (y * w.astype(jnp.float32)).astype(x.dtype)


def axial_rope_tables(rows):
    row = jnp.repeat(jnp.arange(rows, dtype=jnp.float32), GRID_W)
    col = jnp.tile(jnp.arange(GRID_W, dtype=jnp.float32), rows)
    n_freq = HEAD_DIM // 4
    freqs = ROPE_THETA ** (-jnp.arange(n_freq, dtype=jnp.float32) / n_freq)
    ang = jnp.concatenate([row[:, None] * freqs, col[:, None] * freqs], axis=-1)
    return jnp.cos(ang), jnp.sin(ang)


def apply_rope(x, cos, sin):
    half = HEAD_DIM // 2
    x1, x2 = x[..., :half], x[..., half:]
    c = cos[None, :, None, :].astype(x.dtype)
    s = sin[None, :, None, :].astype(x.dtype)
    return jnp.concatenate([x1 * c - x2 * s, x1 * s + x2 * c], axis=-1)


def block_attention(q, k, v):
    b, n = q.shape[:2]
    nb = n // ATTN_BLOCK
    qb = q.reshape(b, nb, ATTN_BLOCK, N_KV_HEADS, Q_PER_KV, HEAD_DIM).transpose(1, 0, 2, 3, 4, 5)
    scale = HEAD_DIM ** -0.5

    def one_block(q_blk):
        s = jnp.einsum('bqkgd,bskd->bkgqs', q_blk, k).astype(jnp.float32) * scale
        p = jax.nn.softmax(s, axis=-1).astype(v.dtype)
        return jnp.einsum('bkgqs,bskd->bqkgd', p, v)

    o = lax.map(one_block, qb)
    return o.transpose(1, 0, 2, 3, 4, 5).reshape(b, n, N_HEADS * HEAD_DIM)


def depthwise_conv_silu(x, w, bias):
    y = lax.conv_general_dilated(
        x, w[:, None, :].astype(x.dtype), window_strides=(1,),
        padding=[(CONV_WIDTH // 2, CONV_WIDTH // 2)],
        dimension_numbers=('NWC', 'WIO', 'NWC'), feature_group_count=x.shape[-1])
    return jax.nn.silu(y + bias.astype(x.dtype))


def ssd_scan(x, dt, A, B, C, h0):
    b, L, H, P = x.shape
    nc = L // SSD_CHUNK
    f32 = jnp.float32
    Bh = jnp.repeat(B.astype(f32), HEADS_PER_GROUP, axis=2).reshape(b, nc, SSD_CHUNK, H, D_STATE)
    Ch = jnp.repeat(C.astype(f32), HEADS_PER_GROUP, axis=2).reshape(b, nc, SSD_CHUNK, H, D_STATE)
    xdt = (x.astype(f32) * dt[..., None]).reshape(b, nc, SSD_CHUNK, H, P)
    acum = jnp.cumsum((dt * A).reshape(b, nc, SSD_CHUNK, H), axis=2)
    lower = jnp.tril(jnp.ones((SSD_CHUNK, SSD_CHUNK), dtype=bool))[None, None, :, :, None]
    seg = acum[:, :, :, None, :] - acum[:, :, None, :, :]
    decay = jnp.exp(jnp.where(lower, seg, -jnp.inf))
    scores = jnp.einsum('bcihn,bcjhn->bcijh', Ch, Bh) * decay
    y_intra = jnp.einsum('bcijh,bcjhp->bcihp', scores, xdt)
    decay_to_end = jnp.exp(acum[:, :, -1:, :] - acum)
    chunk_states = jnp.einsum('bcjhn,bcjh,bcjhp->bchpn', Bh, decay_to_end, xdt)
    chunk_decay = jnp.exp(acum[:, :, -1, :])

    def step(h, inp):
        s_c, d_c = inp
        return h * d_c[:, :, None, None] + s_c, h

    h_final, h_in = lax.scan(step, h0, (chunk_states.transpose(1, 0, 2, 3, 4), chunk_decay.transpose(1, 0, 2)))
    h_in = h_in.transpose(1, 0, 2, 3, 4)
    y_inter = jnp.einsum('bcihn,bcih,bchpn->bcihp', Ch, jnp.exp(acum), h_in)
    return (y_intra + y_inter).reshape(b, L, H, P), h_final


def hybrid_mixer(h_lat, h_ctx, cos, sin, w_in, q_norm, k_norm, conv_w, conv_b, dt_bias_fwd, dt_bias_bwd,
                 a_log_fwd, a_log_bwd, d_skip, ssd_norm, w_out, with_ctx_out):
    b, n_lat, _ = h_lat.shape
    n_ctx = h_ctx.shape[1]
    f32 = jnp.float32
    q_l, k_l, v_l, z_l, xbc_l, dt_l = jnp.split(h_lat @ w_in, IN_SPLITS, axis=-1)
    q_c, k_c, v_c, z_c, xbc_c, dt_c = jnp.split(h_ctx @ w_in, IN_SPLITS, axis=-1)

    def heads(q, k, v, n):
        q = rmsnorm(q.reshape(b, n, N_HEADS, HEAD_DIM), q_norm)
        k = rmsnorm(k.reshape(b, n, N_KV_HEADS, HEAD_DIM), k_norm)
        return q, k, v.reshape(b, n, N_KV_HEADS, HEAD_DIM)

    q_l, k_l, v_l = heads(q_l, k_l, v_l, n_lat)
    q_c, k_c, v_c = heads(q_c, k_c, v_c, n_ctx)
    q_l = apply_rope(q_l, cos, sin)
    k_l = apply_rope(k_l, cos, sin)
    k_all = jnp.concatenate([k_c, k_l], axis=1)
    v_all = jnp.concatenate([v_c, v_l], axis=1)
    attn_l = block_attention(q_l, k_all, v_all)

    def ssd_inputs(xbc, n):
        xbc = depthwise_conv_silu(xbc, conv_w, conv_b)
        xs, Bs, Cs = jnp.split(xbc, (SSD_WIDTH, SSD_WIDTH + BC_DIM), axis=-1)
        return (xs.reshape(b, n, SSD_HEADS, SSD_HEAD_DIM), Bs.reshape(b, n, SSD_GROUPS, D_STATE),
                Cs.reshape(b, n, SSD_GROUPS, D_STATE))

    xs_l, B_l, C_l = ssd_inputs(xbc_l, n_lat)
    xs_c, B_c, C_c = ssd_inputs(xbc_c, n_ctx)
    ys_l, ys_c = [], []
    for dt_bias, a_log, reverse in ((dt_bias_fwd, a_log_fwd, False), (dt_bias_bwd, a_log_bwd, True)):
        A = -jnp.exp(a_log.astype(f32))
        d_l = jax.nn.softplus(dt_l.astype(f32) + dt_bias.astype(f32))
        d_c = jax.nn.softplus(dt_c.astype(f32) + dt_bias.astype(f32))
        flip = (lambda t: jnp.flip(t, axis=1)) if reverse else (lambda t: t)
        h0 = jnp.zeros((b, SSD_HEADS, SSD_HEAD_DIM, D_STATE), f32)
        y_c, h_ctx_final = ssd_scan(flip(xs_c), flip(d_c), A, flip(B_c), flip(C_c), h0)
        y_l, _ = ssd_scan(flip(xs_l), flip(d_l), A, flip(B_l), flip(C_l), h_ctx_final)
        ys_l.append(flip(y_l))
        ys_c.append(flip(y_c))

    def ssd_output(y, xs, z, n):
        y = (y + d_skip.astype(f32)[:, None] * xs.astype(f32)).astype(z.dtype).reshape(b, n, SSD_WIDTH)
        return rmsnorm(y * jax.nn.silu(z), ssd_norm)

    out_l = jnp.concatenate([attn_l, ssd_output(ys_l[0] + ys_l[1], xs_l, z_l, n_lat)], axis=-1) @ w_out
    if not with_ctx_out:
        return out_l, None
    attn_c = block_attention(q_c, k_c, v_c)
    out_c = jnp.concatenate([attn_c, ssd_output(ys_c[0] + ys_c[1], xs_c, z_c, n_ctx)], axis=-1) @ w_out
    return out_l, out_c


def swiglu(h, w_gate, w_up, w_down):
    return (jax.nn.silu(h @ w_gate) * (h @ w_up)) @ w_down


def setup_inputs(seed: int = 0) -> dict:
    key = jax.random.key(seed)
    ks = jax.random.split(key, 24)
    f32 = jnp.float32
    L = DEPTH

    def nrm(k, shape, scale):
        return jax.random.normal(k, shape, f32) * scale

    def gain(k, shape):
        return 1.0 + 0.05 * jax.random.normal(k, shape, f32)

    dt0 = jnp.exp(jax.random.uniform(ks[14], (L, 2, SSD_HEADS), f32, math.log(1e-3), math.log(1e-1)))
    dt_bias = dt0 + jnp.log(-jnp.expm1(-dt0))
    a_log = jnp.log(jax.random.uniform(ks[15], (L, 2, SSD_HEADS), f32, 1.0, 16.0))
    nk = jax.random.split(ks[6], 4)
    return {
        'x': nrm(ks[0], (BATCH, SEQ, D_MODEL), 1.0),
        'c': nrm(ks[1], (BATCH, D_MODEL), 1.0),
        'ctx': nrm(ks[2], (BATCH, CTX_LEN, D_MODEL), 1.0),
        'c_ctx': nrm(ks[3], (D_MODEL,), 1.0),
        'w_mod': nrm(ks[4], (L, D_MODEL, N_MOD * D_MODEL), 0.5 * D_MODEL ** -0.5),
        'b_mod': nrm(ks[5], (L, N_MOD * D_MODEL), 0.02),
        'norm_mix_pre': gain(nk[0], (L, D_MODEL)),
        'norm_mix_post': gain(nk[1], (L, D_MODEL)),
        'norm_ffn_pre': gain(nk[2], (L, D_MODEL)),
        'norm_ffn_post': gain(nk[3], (L, D_MODEL)),
        'w_in': nrm(ks[10], (L, D_MODEL, IN_DIM), D_MODEL ** -0.5),
        'q_norm': gain(ks[11], (L, HEAD_DIM)),
        'k_norm': gain(ks[12], (L, HEAD_DIM)),
        'conv_w': nrm(ks[13], (L, CONV_WIDTH, XBC_DIM), CONV_WIDTH ** -0.5),
        'conv_b': nrm(ks[16], (L, XBC_DIM), 0.02),
        'dt_bias_fwd': dt_bias[:, 0],
        'dt_bias_bwd': dt_bias[:, 1],
        'a_log_fwd': a_log[:, 0],
        'a_log_bwd': a_log[:, 1],
        'd_skip': 1.0 + 0.1 * jax.random.normal(ks[17], (L, SSD_HEADS), f32),
        'ssd_norm': gain(ks[18], (L, SSD_WIDTH)),
        'w_out': nrm(ks[19], (L, D_MODEL, D_MODEL), D_MODEL ** -0.5),
        'w_gate': nrm(ks[20], (L, D_MODEL, D_FF), D_MODEL ** -0.5),
        'w_up': nrm(ks[21], (L, D_MODEL, D_FF), D_MODEL ** -0.5),
        'w_down': nrm(ks[22], (L, D_FF, D_MODEL), D_FF ** -0.5),
    }


def reference(x, c, ctx, c_ctx, w_mod, b_mod, norm_mix_pre, norm_mix_post, norm_ffn_pre, norm_ffn_post,
              w_in, q_norm, k_norm, conv_w, conv_b, dt_bias_fwd, dt_bias_bwd, a_log_fwd, a_log_bwd, d_skip,
              ssd_norm, w_out, w_gate, w_up, w_down):
    n_lat = x.shape[1]
    rows = n_lat // GRID_W
    cos, sin = axial_rope_tables(rows)
    silu_c = jax.nn.silu(c)
    silu_cc = jax.nn.silu(c_ctx)
    x_lat, x_ctx = x, ctx
    for l in range(DEPTH):
        update_ctx = l < DEPTH - 1
        mod_l = (silu_c @ w_mod[l] + b_mod[l])[:, None, :]
        mod_c = (silu_cc @ w_mod[l] + b_mod[l])[None, None, :]
        sh1_l, sc1_l, g1_l, sh2_l, sc2_l, g2_l = jnp.split(mod_l, N_MOD, axis=-1)
        sh1_c, sc1_c, g1_c, sh2_c, sc2_c, g2_c = jnp.split(mod_c, N_MOD, axis=-1)

        h_l = rmsnorm(x_lat, norm_mix_pre[l]) * (1.0 + sc1_l) + sh1_l
        h_c = rmsnorm(x_ctx, norm_mix_pre[l]) * (1.0 + sc1_c) + sh1_c
        m_l, m_c = hybrid_mixer(h_l, h_c, cos, sin, w_in[l], q_norm[l], k_norm[l], conv_w[l], conv_b[l],
                                dt_bias_fwd[l], dt_bias_bwd[l], a_log_fwd[l], a_log_bwd[l], d_skip[l],
                                ssd_norm[l], w_out[l], update_ctx)
        x_lat = x_lat + g1_l * rmsnorm(m_l, norm_mix_post[l])

        f_l = rmsnorm(x_lat, norm_ffn_pre[l]) * (1.0 + sc2_l) + sh2_l
        x_lat = x_lat + g2_l * rmsnorm(swiglu(f_l, w_gate[l], w_up[l], w_down[l]), norm_ffn_post[l])

        if update_ctx:
            x_ctx = x_ctx + g1_c * rmsnorm(m_c, norm_mix_post[l])
            f_c = rmsnorm(x_ctx, norm_ffn_pre[l]) * (1.0 + sc2_c) + sh2_c
            x_ctx = x_ctx + g2_c * rmsnorm(swiglu(f_c, w_gate[l], w_up[l], w_down[l]), norm_ffn_post[l])
    return x_lat
```

```cpp
#include <hip/hip_runtime.h>
#include <hip/hip_cooperative_groups.h>
#include <hip/hip_bf16.h>
#include <cstdio>
#include <cstdint>
#include <cmath>
namespace cg = cooperative_groups;
#ifndef PHM
#define PHM 0xffff
#endif
#ifndef REPM
#define REPM 0
#endif
namespace pg8 {
#define PG8_LAS __attribute__((address_space(3)))
typedef unsigned short bf16_t;
typedef short bf16x8 __attribute__((ext_vector_type(8)));
typedef float f32x4 __attribute__((ext_vector_type(4)));
typedef unsigned u32x4 __attribute__((ext_vector_type(4)));
constexpr int BM = 256, BK = 64, HALF = 128, HTB = HALF * BK * 2  , STAGE_BYTES = 8 * HTB, NXCD = 8, WGM = 8;

__host__ __device__ __forceinline__ int lds_byte(int r, int c) { const int st = (r >> 4) * 2 + (c >> 5), rr = r & 15, cc = c & 31, ob = rr * 64 + cc * 2; return st * 1024 + (ob ^ (((ob >> 9) & 1) << 5)); }
__host__ __device__ __forceinline__ void stage_rc(int b, int& R, int& C) { const int st = b / 1024, sb = b % 1024, swz = sb ^ (((sb >> 9) & 1) << 5); R = (st >> 1) * 16 + swz / 64; C = (st & 1) * 32 + (swz % 64) / 2; }
__host__ __device__ __forceinline__ int perm32(int rho) { const int n = rho >> 4, i = rho & 15; return 8 * (i >> 2) + 4 * n + (i & 3); }

struct Unit { int pm, pn; };
struct Gemm { const bf16_t* A; const bf16_t* Bt; int M, N, K; };

struct StaticOrder {
    int nM, nN, nwg, G, c;
    __host__ __device__ void init(int M, int N, int G_, int c_) { nM = M / BM; nN = N / BM; nwg = nM * nN; G = G_; c = c_; }
    __host__ __device__ __forceinline__ bool next(int i, Unit& u) const {
        const long L = (long)i * G + c; if (L >= nwg) return false;
        int wgid = (int)L; { const int q = nwg / NXCD, r = nwg % NXCD, xcd = wgid % NXCD, off = wgid / NXCD; wgid = (xcd < r ? xcd * (q + 1) : r * (q + 1) + (xcd - r) * q) + off; }
        const int nig = WGM * nN, gid = wgid / nig, fm = gid * WGM, gsz = (nM - fm) < WGM ? (nM - fm) : WGM;
        u.pm = fm + ((wgid % nig) % gsz); u.pn = (wgid % nig) / gsz; return true;
    }
    __device__ __forceinline__ void a_ready(const Unit&) const {}
    __device__ __forceinline__ void done(const Unit&) const {}
};

__device__ __forceinline__ unsigned cvt_pk_bf16(float lo, float hi) { unsigned r; asm volatile("v_cvt_pk_bf16_f32 %0, %1, %2" : "=v"(r) : "v"(lo), "v"(hi)); return r; }
typedef float f32x2 __attribute__((ext_vector_type(2)));
typedef float f32x2 __attribute__((ext_vector_type(2)));
template <class Epi, class Sched, bool ALIGN_EPI = false, bool SP2 = false>
__device__ __forceinline__ void gemm_phase(PG8_LAS unsigned char* lds, const Gemm g, const Sched& S, const Epi& E) {
    int tid_ = threadIdx.x; asm volatile("" : "+v"(tid_));
    const int tid = tid_, wid = __builtin_amdgcn_readfirstlane(tid >> 6), lane = tid & 63, wr = wid >> 2, wc = wid & 3, fr = lane & 15, fq = lane >> 4;
    const int K = g.K, nt = K / BK;
    unsigned voffA[2], voffB[2];
#pragma unroll
    for (int i = 0; i < 2; ++i) { int R, C; stage_rc(tid * 16 + i * 8192, R, C); const int Rb = Epi::PERM ? ((R & ~31) + perm32(R & 31)) : R;
        voffA[i] = (unsigned)(R * K + C) * 2u; voffB[i] = (unsigned)(Rb * K + C) * 2u; }
    const size_t kstep = (size_t)(BK * 2);
    const size_t hstep = (size_t)HALF * K * 2;
    const size_t tstep = 2 * hstep;
    const unsigned ldsw = (unsigned)wid * 1024u;
    const int aoff = lds_byte(wr * 64 + fr, fq * 8), boff = lds_byte(wc * 32 + fr, fq * 8);
#define PG8_SA(b, h) (((b) * 2 + (h)) * HTB)
#define PG8_SB(b, h) ((4 + (b) * 2 + (h)) * HTB)
#define PG8_STAGE(bufoff, gbase, voff) do { _Pragma("unroll") for (int _i = 0; _i < 2; ++_i) \
        __builtin_amdgcn_global_load_lds((const unsigned*)((const char*)(gbase) + (voff)[_i]), (PG8_LAS unsigned*)(lds + (bufoff) + ldsw + _i * 8192), 16, 0, 0); } while (0)
#define PG8_LDA(dst, b, h) do { _Pragma("unroll") for (int m = 0; m < 4; ++m) _Pragma("unroll") for (int k = 0; k < 2; ++k) dst[m][k] = *(const PG8_LAS bf16x8*)(lds + PG8_SA(b, h) + aoff + m * 2048 + k * 1024); } while (0)
#define PG8_LDB(dst, b, h) do { _Pragma("unroll") for (int n = 0; n < 2; ++n) _Pragma("unroll") for (int k = 0; k < 2; ++k) dst[n][k] = *(const PG8_LAS bf16x8*)(lds + PG8_SB(b, h) + boff + n * 2048 + k * 1024); } while (0)
#define PG8_MMA(ai, bj, At, Bt) do { __builtin_amdgcn_s_setprio(1); _Pragma("unroll") for (int m = 0; m < 4; ++m) _Pragma("unroll") for (int n = 0; n < 2; ++n) _Pragma("unroll") for (int k = 0; k < 2; ++k) \
        acc[ai][bj][m][n] = __builtin_amdgcn_mfma_f32_16x16x32_bf16(Bt[n][k], At[m][k], acc[ai][bj][m][n], 0, 0, 0); __builtin_amdgcn_s_setprio(0); } while (0)
#define PG8_WAIT_V(n) asm volatile("s_waitcnt vmcnt(" #n ")" ::: "memory")
#define PG8_WAIT_L(n) asm volatile("s_waitcnt lgkmcnt(" #n ")" ::: "memory")
#define PG8_BAR __builtin_amdgcn_s_barrier()
#define PG8_SCHED __builtin_amdgcn_sched_barrier(0)
    Unit cur, nxt; int ui = 0;
    if (!S.next(0, cur)) return;
    f32x4 acc[2][2][4][2];
#pragma unroll
    for (int a = 0; a < 2; ++a)
#pragma unroll
        for (int b = 0; b < 2; ++b)
#pragma unroll
            for (int m = 0; m < 4; ++m)
#pragma unroll
                for (int n = 0; n < 2; ++n) acc[a][b][m][n] = (f32x4){0.f, 0.f, 0.f, 0.f};
    bf16x8 At[4][2], B0[2][2], B1[2][2];
    const char* cA = (const char*)g.A + (size_t)cur.pm * tstep; const char* cB = (const char*)g.Bt + (size_t)cur.pn * tstep;
    S.a_ready(cur);
    if constexpr (SP2) {
        PG8_STAGE(PG8_SB(0, 0), cB, voffB); PG8_STAGE(PG8_SB(0, 1), cB + hstep, voffB); PG8_STAGE(PG8_SA(0, 0), cA, voffA); PG8_STAGE(PG8_SA(0, 1), cA + hstep, voffA);
        if (wr == 1) PG8_BAR;
        PG8_WAIT_V(2); PG8_BAR;
        PG8_STAGE(PG8_SB(1, 0), cB + kstep, voffB); PG8_STAGE(PG8_SA(1, 0), cA + kstep, voffA); PG8_STAGE(PG8_SB(1, 1), cB + hstep + kstep, voffB);
        PG8_WAIT_V(6); PG8_BAR;
    } else {
        PG8_STAGE(PG8_SB(0, 0), cB, voffB); PG8_STAGE(PG8_SA(0, 0), cA, voffA); PG8_STAGE(PG8_SB(0, 1), cB + hstep, voffB); PG8_STAGE(PG8_SA(0, 1), cA + hstep, voffA);
        if (wr == 1) PG8_BAR;
        PG8_WAIT_V(4); PG8_BAR;
        PG8_STAGE(PG8_SB(1, 0), cB + kstep, voffB); PG8_STAGE(PG8_SA(1, 0), cA + kstep, voffA); PG8_STAGE(PG8_SB(1, 1), cB + hstep + kstep, voffB);
        PG8_WAIT_V(6); PG8_BAR;
    }
    for (;;) {
        const bool has_next = S.next(ui + 1, nxt);
        const char* nA = has_next ? (const char*)g.A + (size_t)nxt.pm * tstep : cA; const char* nB = has_next ? (const char*)g.Bt + (size_t)nxt.pn * tstep : cB;
        for (int t = 0; t < nt; t += 2) {
            const bool last = (t == nt - 2);
            const char* a1 = cA + (size_t)(t + 1) * kstep;
            const char* a2 = last ? nA : cA + (size_t)(t + 2) * kstep; const char* b2 = last ? nB : cB + (size_t)(t + 2) * kstep;
            const char* a3 = a2 + kstep; const char* b3 = b2 + kstep;
            if (last && has_next) S.a_ready(nxt);
            if constexpr (SP2) {
            PG8_LDB(B0, 0, 0); PG8_LDB(B1, 0, 1); PG8_SCHED; PG8_LDA(At, 0, 0); PG8_STAGE(PG8_SA(1, 1), a1 + hstep, voffA);
            PG8_WAIT_V(8); PG8_WAIT_L(0); PG8_BAR; PG8_MMA(0, 0, At, B0); PG8_MMA(0, 1, At, B1); PG8_BAR; PG8_SCHED;
            PG8_LDA(At, 0, 1); PG8_STAGE(PG8_SB(0, 0), b2, voffB); PG8_STAGE(PG8_SB(0, 1), b2 + hstep, voffB); PG8_STAGE(PG8_SA(0, 0), a2, voffA);
            PG8_WAIT_V(8); PG8_WAIT_L(0); PG8_BAR; PG8_MMA(1, 0, At, B0); PG8_MMA(1, 1, At, B1); PG8_BAR; PG8_SCHED;
            PG8_LDB(B0, 1, 0); PG8_LDB(B1, 1, 1); PG8_SCHED; PG8_LDA(At, 1, 0); PG8_STAGE(PG8_SA(0, 1), a2 + hstep, voffA);
            PG8_WAIT_V(8); PG8_WAIT_L(0); PG8_BAR; PG8_MMA(0, 0, At, B0); PG8_MMA(0, 1, At, B1); PG8_BAR; PG8_SCHED;
            PG8_LDA(At, 1, 1); PG8_STAGE(PG8_SB(1, 0), b3, voffB); PG8_STAGE(PG8_SB(1, 1), b3 + hstep, voffB); PG8_STAGE(PG8_SA(1, 0), a3, voffA);
            PG8_WAIT_V(8); PG8_WAIT_L(0); PG8_BAR; PG8_MMA(1, 0, At, B0); PG8_MMA(1, 1, At, B1); PG8_BAR; PG8_SCHED;
            } else {
            PG8_LDB(B0, 0, 0); PG8_SCHED; PG8_LDA(At, 0, 0); PG8_STAGE(PG8_SA(1, 1), a1 + hstep, voffA);
            PG8_WAIT_L(8); PG8_BAR; PG8_WAIT_L(0); PG8_MMA(0, 0, At, B0); PG8_BAR; PG8_SCHED;
            PG8_LDB(B1, 0, 1); PG8_STAGE(PG8_SB(0, 0), b2, voffB);
            PG8_BAR; PG8_WAIT_L(0); PG8_MMA(0, 1, At, B1); PG8_BAR;
            PG8_LDA(At, 0, 1); PG8_STAGE(PG8_SA(0, 0), a2, voffA);
            PG8_BAR; PG8_WAIT_L(0); PG8_MMA(1, 0, At, B0); PG8_BAR; PG8_SCHED;
            PG8_STAGE(PG8_SB(0, 1), b2 + hstep, voffB);
            PG8_WAIT_V(6); PG8_BAR; PG8_MMA(1, 1, At, B1); PG8_BAR;
            PG8_LDB(B0, 1, 0); PG8_SCHED; PG8_LDA(At, 1, 0); PG8_STAGE(PG8_SA(0, 1), a2 + hstep, voffA);
            PG8_WAIT_L(8); PG8_BAR; PG8_WAIT_L(0); PG8_MMA(0, 0, At, B0); PG8_BAR; PG8_SCHED;
            PG8_LDB(B1, 1, 1); PG8_STAGE(PG8_SB(1, 0), b3, voffB);
            PG8_BAR; PG8_WAIT_L(0); PG8_MMA(0, 1, At, B1); PG8_BAR;
            PG8_LDA(At, 1, 1); PG8_STAGE(PG8_SA(1, 0), a3, voffA);
            PG8_BAR; PG8_WAIT_L(0); PG8_MMA(1, 0, At, B0); PG8_BAR; PG8_SCHED;
            PG8_STAGE(PG8_SB(1, 1), b3 + hstep, voffB);
            PG8_WAIT_V(6); PG8_BAR; PG8_MMA(1, 1, At, B1); PG8_BAR;
            }
        }
        if constexpr (ALIGN_EPI) { if (wr == 0) PG8_BAR; }
        if constexpr (!Epi::AFTER_DRAIN) { E(acc, cur, wr, wc, fr, fq); S.done(cur); }
        if (!has_next) break;
#pragma unroll
        for (int a = 0; a < 2; ++a)
#pragma unroll
            for (int b = 0; b < 2; ++b)
#pragma unroll
                for (int m = 0; m < 4; ++m)
#pragma unroll
                    for (int n = 0; n < 2; ++n) acc[a][b][m][n] = (f32x4){0.f, 0.f, 0.f, 0.f};
        cur = nxt; cA = nA; cB = nB; ++ui;
        if constexpr (ALIGN_EPI) { if (wr == 1) PG8_BAR; }
    }
    PG8_WAIT_V(0);
    if constexpr (!ALIGN_EPI) { if (wr == 0) PG8_BAR; }
    PG8_BAR;
    if constexpr (Epi::AFTER_DRAIN) { E.fused(acc, cur, wr, wc, fr, fq, lds, wid, lane); S.done(cur); }
#undef PG8_SA
#undef PG8_SB
#undef PG8_STAGE
#undef PG8_LDA
#undef PG8_LDB
#undef PG8_MMA
#undef PG8_WAIT_V
#undef PG8_WAIT_L
#undef PG8_BAR
#undef PG8_SCHED
}
}
namespace pg8 {
struct EpiStoreBf16 {
    static constexpr bool PERM = true, AFTER_DRAIN = false;
    bf16_t* O0; int ld0; bf16_t* O1; int ld1; int split_pn;
    __device__ __forceinline__ void operator()(const f32x4 (&acc)[2][2][4][2], const Unit& u, int wr, int wc, int fr, int fq) const {
        const int row0 = u.pm * BM + wr * 64 + fr;
        bf16_t* base; int ld, colt;
        if (u.pn < split_pn) { base = O0; ld = ld0; colt = u.pn * BM; } else { base = O1; ld = ld1; colt = (u.pn - split_pn) * BM; }
        const int col0 = colt + wc * 32 + 8 * fq;
#pragma unroll
        for (int ai = 0; ai < 2; ++ai)
#pragma unroll
            for (int m = 0; m < 4; ++m) { bf16_t* rowp = base + (size_t)(row0 + ai * HALF + m * 16) * ld + col0;
#pragma unroll
                for (int bj = 0; bj < 2; ++bj) { const f32x4 v0 = acc[ai][bj][m][0], v1 = acc[ai][bj][m][1];
                    u32x4 w; w.x = cvt_pk_bf16(v0[0], v0[1]); w.y = cvt_pk_bf16(v0[2], v0[3]); w.z = cvt_pk_bf16(v1[0], v1[1]); w.w = cvt_pk_bf16(v1[2], v1[3]);
                    *(u32x4*)(rowp + bj * HALF) = w; } }
    }
};
struct EpiSwiGLU {
    static constexpr bool PERM = true, AFTER_DRAIN = false;
    bf16_t* O; int ldc;
    __device__ __forceinline__ void operator()(const f32x4 (&acc)[2][2][4][2], const Unit& u, int wr, int wc, int fr, int fq) const {
        const int row0 = u.pm * BM + wr * 64 + fr;
        const int col0 = u.pn * 128 + wc * 32 + 8 * fq;
#pragma unroll
        for (int ai = 0; ai < 2; ++ai)
#pragma unroll
            for (int m = 0; m < 4; ++m) { bf16_t* rowp = O + (size_t)(row0 + ai * HALF + m * 16) * ldc + col0; f32x4 o[2];
#pragma unroll
                for (int n = 0; n < 2; ++n) { const f32x4 g = acc[ai][0][m][n], up = acc[ai][1][m][n];
#pragma unroll
                    for (int e = 0; e < 4; ++e) o[n][e] = g[e] * up[e] * __builtin_amdgcn_rcpf(1.0f + __expf(-g[e])); }
                u32x4 w; w.x = cvt_pk_bf16(o[0][0], o[0][1]); w.y = cvt_pk_bf16(o[0][2], o[0][3]); w.z = cvt_pk_bf16(o[1][0], o[1][1]); w.w = cvt_pk_bf16(o[1][2], o[1][3]);
                *(u32x4*)rowp = w; }
    }
};
struct EpiRmsRes {
    static constexpr bool PERM = false, AFTER_DRAIN = true;
    const float* base; float* out; int ldc; const float* gate; const float* w; float* slots; unsigned* cnt; float eps;
    __device__ __forceinline__ void fused(f32x4 (&acc)[2][2][4][2], const Unit& u, int wr, int wc, int fr, int fq, PG8_LAS unsigned char* lds, int wid, int lane) const {
        PG8_LAS float* P = (PG8_LAS float*)lds;
        PG8_LAS float* S = (PG8_LAS float*)(lds + 4096);
#pragma unroll
        for (int ai = 0; ai < 2; ++ai)
#pragma unroll
            for (int m = 0; m < 4; ++m) { float s = 0.f;
#pragma unroll
                for (int bj = 0; bj < 2; ++bj)
#pragma unroll
                    for (int n = 0; n < 2; ++n) { const f32x4 x = acc[ai][bj][m][n]; s += (x[0] * x[0] + x[1] * x[1]) + (x[2] * x[2] + x[3] * x[3]); }
                s += __shfl_xor(s, 16); s += __shfl_xor(s, 32);
                if (fq == 0) P[(ai * HALF + wr * 64 + m * 16 + fr) * 4 + wc] = s; }
        asm volatile("s_waitcnt lgkmcnt(0)" ::: "memory"); __builtin_amdgcn_s_barrier(); asm volatile("" ::: "memory");
        const int row = wid * 32 + (lane & 31);
        if (lane < 32) { const float t = (P[row * 4 + 0] + P[row * 4 + 1]) + (P[row * 4 + 2] + P[row * 4 + 3]);
            __hip_atomic_store((unsigned*)slots + ((size_t)(u.pm * BM + row) * 4 + u.pn), __builtin_bit_cast(unsigned, t), __ATOMIC_RELAXED, __HIP_MEMORY_SCOPE_AGENT); }
        asm volatile("s_waitcnt vmcnt(0)" ::: "memory");
        if (lane == 0) __hip_atomic_fetch_add(cnt + 64 * u.pm, 1u, __ATOMIC_RELAXED, __HIP_MEMORY_SCOPE_AGENT);
        if (wid == 0) { unsigned sp = 0;
            while ((unsigned)__builtin_amdgcn_readfirstlane(__hip_atomic_load(cnt + 64 * u.pm, __ATOMIC_RELAXED, __HIP_MEMORY_SCOPE_AGENT)) < 32u) { __builtin_amdgcn_s_sleep(2); if (++sp > (1u << 20)) break; }
            __builtin_amdgcn_fence(__ATOMIC_ACQUIRE, "agent"); }
        asm volatile("s_waitcnt vmcnt(0) lgkmcnt(0)" ::: "memory"); __builtin_amdgcn_s_barrier(); asm volatile("" ::: "memory");
        if (lane < 32) { const unsigned* sl = (const unsigned*)slots + (size_t)(u.pm * BM + row) * 4; float t = 0.f;
#pragma unroll
            for (int k = 0; k < 4; ++k) t += __builtin_bit_cast(float, __hip_atomic_load(sl + k, __ATOMIC_RELAXED, __HIP_MEMORY_SCOPE_AGENT));
            S[row] = 1.0f / sqrtf(t * (1.0f / 1024.0f) + eps); }
        asm volatile("s_waitcnt lgkmcnt(0)" ::: "memory"); __builtin_amdgcn_s_barrier(); asm volatile("" ::: "memory");
        const int col0 = u.pn * BM + wc * 32 + 4 * fq;
#pragma unroll
        for (int bj = 0; bj < 2; ++bj)
#pragma unroll
            for (int n = 0; n < 2; ++n) { const f32x4 gw = *(const f32x4*)(gate + col0 + bj * HALF + n * 16) * *(const f32x4*)(w + col0 + bj * HALF + n * 16);
#pragma unroll
                for (int ai = 0; ai < 2; ++ai)
#pragma unroll
                    for (int m = 0; m < 4; ++m) { const int r = ai * HALF + wr * 64 + m * 16 + fr; const float rs = S[r]; const size_t off = (size_t)(u.pm * BM + r) * ldc + col0 + bj * HALF + n * 16;
                        __builtin_nontemporal_store(__builtin_nontemporal_load((const f32x4*)(base + off)) + gw * (acc[ai][bj][m][n] * rs), (f32x4*)(out + off)); if (m & 1) asm volatile("" ::: "memory"); } }
    }
};
}
#ifndef PG8_SP2
#define PG8_SP2 true
#endif
#ifndef PG8_ALIGN
#define PG8_ALIGN true
#endif
namespace attn_body {
using bf16=__hip_bfloat16;
using bf16x8=__attribute__((ext_vector_type(8)))short;
using s16x4=__attribute__((ext_vector_type(4)))short;
using f32x16=__attribute__((ext_vector_type(16)))float;
using u32x4=__attribute__((ext_vector_type(4)))unsigned;
constexpr int D=64,QP=1024,KP=128;
constexpr int NW=8,QBLK=32,QB=QBLK*NW,KVBLK=64;
constexpr int ATTN_UNIT_ROWS=QB;
__device__ __forceinline__ int crow(int r,int hi){return (r&3)+8*(r>>2)+4*hi;}
#define SBAR() __builtin_amdgcn_sched_barrier(0)
__device__ __forceinline__ void cmask(f32x16&p0,f32x16&p1,int jb,int qrel,int hi){
  const float NEG=-INFINITY; int kb=64*jb+4*hi;
  #pragma unroll
  for(int r=0;r<16;++r){int kv=kb+(r&3)+8*(r>>2); if(kv>qrel)p0[r]=NEG; if(kv+32>qrel)p1[r]=NEG;}
}

constexpr int NSLOT=3, SLOTB=8192;
constexpr int LDS_K=0, LDS_V=NSLOT*SLOTB, LDS_WS=2*NSLOT*SLOTB, LDS_OST=LDS_WS+NW*64*4, LDS_BYTES=LDS_OST+NW*4096;
constexpr float C2=0.125f*1.4426950408889634f;
__device__ __forceinline__ void glds16(const void*gsrc,unsigned lds_dst){unsigned keep;
  asm volatile("s_mov_b32 %0, m0\n\ts_mov_b32 m0, %2\n\ts_nop 0\n\tglobal_load_lds_dwordx4 %1, off\n\ts_mov_b32 m0, %0":"=&s"(keep):"v"(gsrc),"s"(lds_dst):"memory");}
__device__ __forceinline__ float max3f(float a,float b,float c){float r;asm("v_max3_f32 %0, %1, %2, %3":"=v"(r):"v"(a),"v"(b),"v"(c));return r;}
__device__ __forceinline__ float max2f(float a,float b){float r;asm("v_max_f32_e32 %0, %1, %2":"=v"(r):"v"(a),"v"(b));return r;}
__device__ __forceinline__ float fadd_s(float a,float b){float r;asm("v_add_f32_e32 %0, %1, %2":"=v"(r):"v"(a),"v"(b));return r;}
__device__ __forceinline__ float fsub_s(float a,float b){float r;asm("v_sub_f32_e32 %0, %1, %2":"=v"(r):"v"(a),"v"(b));return r;}
typedef float f32x2_t __attribute__((ext_vector_type(2))); typedef __bf16 bf16x2_t __attribute__((ext_vector_type(2)));
__device__ __forceinline__ unsigned cvtpk_s(float lo,float hi){f32x2_t v={lo,hi};bf16x2_t b=__builtin_convertvector(v,bf16x2_t);return __builtin_bit_cast(unsigned,b);}
#define WAIT_BAR(N) asm volatile("s_waitcnt vmcnt(" #N ") lgkmcnt(0)\n\ts_barrier":::"memory")

__device__ __forceinline__ void qkt(f32x16&p0,f32x16&p1,const char*Kslot,const bf16x8*qr,const f32x16&negm,int r32,int hi){
  const char*kb=Kslot+hi*1024+r32*16;
  #pragma unroll
  for(int d0=0;d0<4;++d0){
    const bf16x8 b0=*reinterpret_cast<const bf16x8*>(kb+d0*2048);
    const bf16x8 b1=*reinterpret_cast<const bf16x8*>(kb+d0*2048+512);
    if(d0==0){p0=__builtin_amdgcn_mfma_f32_32x32x16_bf16(b0,qr[0],negm,0,0,0);p1=__builtin_amdgcn_mfma_f32_32x32x16_bf16(b1,qr[0],negm,0,0,0);}
    else{p0=__builtin_amdgcn_mfma_f32_32x32x16_bf16(b0,qr[d0],p0,0,0,0);p1=__builtin_amdgcn_mfma_f32_32x32x16_bf16(b1,qr[d0],p1,0,0,0);}}
}
typedef __attribute__((address_space(3))) const char* lds_cptr;
typedef short v4i16_t __attribute__((ext_vector_type(4)));
__device__ __forceinline__ void kload8(bf16x8*kf,lds_cptr kp){
  kf[0]=*(const __attribute__((address_space(3))) bf16x8*)(kp);      kf[1]=*(const __attribute__((address_space(3))) bf16x8*)(kp+512);
  kf[2]=*(const __attribute__((address_space(3))) bf16x8*)(kp+2048); kf[3]=*(const __attribute__((address_space(3))) bf16x8*)(kp+2560);
  kf[4]=*(const __attribute__((address_space(3))) bf16x8*)(kp+4096); kf[5]=*(const __attribute__((address_space(3))) bf16x8*)(kp+4608);
  kf[6]=*(const __attribute__((address_space(3))) bf16x8*)(kp+6144); kf[7]=*(const __attribute__((address_space(3))) bf16x8*)(kp+6656);
}
__device__ __forceinline__ void kload2(bf16x8*kf,lds_cptr kp,int j){ kf[2*j]=*(const __attribute__((address_space(3))) bf16x8*)(kp+j*2048); kf[2*j+1]=*(const __attribute__((address_space(3))) bf16x8*)(kp+j*2048+512); }
__device__ __forceinline__ s16x4 vtr(lds_cptr p){ return __builtin_bit_cast(s16x4,__builtin_amdgcn_ds_read_tr16_b64_v4i16((__attribute__((address_space(3))) v4i16_t*)p)); }
__device__ __forceinline__ float rowmax(const f32x16&p0,const f32x16&p1){
  float a=max3f(p0[0],p0[1],p1[0]),b=max3f(p0[2],p0[3],p1[1]);a=max3f(a,p1[2],p1[3]);
  #pragma unroll
  for(int r=4;r<16;r+=4){a=max3f(a,p0[r],p0[r+1]);b=max3f(b,p0[r+2],p0[r+3]);a=max3f(a,p1[r],p1[r+1]);b=max3f(b,p1[r+2],p1[r+3]);}
  const float m=max2f(a,b);
  auto rr=__builtin_amdgcn_permlane32_swap(__float_as_uint(m),__float_as_uint(m),false,false);
  return max2f(__uint_as_float(rr[0]),__uint_as_float(rr[1]));
}
__device__ __forceinline__ void pv(f32x16*o,int vb,bf16x8 pa0,bf16x8 pa1,bf16x8 pa2,bf16x8 pa3){
  #pragma unroll
  for(int d0=0;d0<2;++d0){s16x4 lo[4],hi[4];
    #pragma unroll
    for(int ks=0;ks<4;++ks){
      asm volatile("ds_read_b64_tr_b16 %0,%1 offset:%c2":"=&v"(lo[ks]):"v"(vb),"i"(d0*4096+ks*1024):"memory");
      asm volatile("ds_read_b64_tr_b16 %0,%1 offset:%c2":"=&v"(hi[ks]):"v"(vb),"i"(d0*4096+ks*1024+512):"memory");}
    asm volatile("s_waitcnt lgkmcnt(0)":::"memory");SBAR();
    #define PK(k) (bf16x8){lo[k][0],lo[k][1],lo[k][2],lo[k][3],hi[k][0],hi[k][1],hi[k][2],hi[k][3]}
    o[d0]=__builtin_amdgcn_mfma_f32_32x32x16_bf16(pa0,PK(0),o[d0],0,0,0);
    o[d0]=__builtin_amdgcn_mfma_f32_32x32x16_bf16(pa1,PK(1),o[d0],0,0,0);
    o[d0]=__builtin_amdgcn_mfma_f32_32x32x16_bf16(pa2,PK(2),o[d0],0,0,0);
    o[d0]=__builtin_amdgcn_mfma_f32_32x32x16_bf16(pa3,PK(3),o[d0],0,0,0);
    #undef PK
  }
}

#ifndef ATTN_STORE16
#define ATTN_STORE16(p,v) (*(u32x4*)(p)=(v))
#endif
template<int THRL,int OP=1024> __device__ __forceinline__ void attn_unit(const bf16*Qb,const bf16*__restrict__ Kh,const bf16*__restrict__ Vh,bf16*Ob,const int NT,char*shm){
  int tid_=threadIdx.x; asm volatile("":"+v"(tid_)); const int tid=tid_,lane=tid&63,r32=lane&31,hi=lane>>5; const int wid=__builtin_amdgcn_readfirstlane(tid>>6);
  const bf16*Qw=Qb+(long)(wid*QBLK)*QP;
  const unsigned lds0=(unsigned)(uintptr_t)shm;
  float*wsf=(float*)(shm+LDS_WS)+wid*64;
  const bf16*ksrc=Kh+(long)lane*KP+wid*8;
  const bf16*vsrc=Vh+(long)(16*(wid&3)+(lane>>2))*KP+(wid>>2)*32+(lane&3)*8;
  const unsigned kdst=lds0+LDS_K+wid*1024, vdst=lds0+LDS_V+wid*1024;
  #define DMA_K(t,slot) glds16(ksrc+(long)(t)*KVBLK*KP,(unsigned)__builtin_amdgcn_readfirstlane(kdst+(slot)))
  #define DMA_V(t,slot) glds16(vsrc+(long)(t)*KVBLK*KP,(unsigned)__builtin_amdgcn_readfirstlane(vdst+(slot)))
  const int vb0=(int)(lds0+LDS_V)+((lane>>4)&1)*32+(lane&3)*8+(4*hi+((lane&15)>>2))*64;
  const char*Kbase=shm+LDS_K; bf16x8 kf[8];
  const lds_cptr shm3=(lds_cptr)shm; const lds_cptr kp0=shm3+LDS_K+hi*1024+r32*16; const lds_cptr vp0=shm3+LDS_V+((lane>>4)&1)*32+(lane&3)*8+(4*hi+((lane&15)>>2))*64;
  DMA_K(0,0);DMA_V(0,0);DMA_K(1,SLOTB);
  bf16x8 qr[4];
  #pragma unroll
  for(int d0=0;d0<4;++d0)qr[d0]=*reinterpret_cast<const bf16x8*>(&Qw[(long)r32*QP+d0*16+hi*8]);
  float mhat=0.f,l_reg=0.f;f32x16 o[2];o[0]=f32x16{};o[1]=f32x16{};f32x16 negm=f32x16{};asm volatile("":"+v"(negm));
  #define CMASK(P0,P1,t) do{}while(0)
  bool resc=false;
  #define START(P0,P1) do{ const float rm=rowmax(P0,P1); resc=false; \
    { const float dl=rm; mhat=fadd_s(mhat,dl); \
      _Pragma("unroll") for(int r=0;r<16;++r){P0[r]=fsub_s(P0[r],dl);P1[r]=fsub_s(P1[r],dl);} \
      _Pragma("unroll") for(int r=0;r<16;++r)negm[r]=-mhat; asm volatile("":"+v"(negm)); } \
    _Pragma("unroll") for(int r=0;r<16;++r)P0[r]=__builtin_amdgcn_exp2f(P0[r]); }while(0)
  #define RESC() do{ if(resc){ asm volatile("s_waitcnt lgkmcnt(0)":::"memory"); \
      _Pragma("unroll") for(int d_=0;d_<2;++d_) _Pragma("unroll") for(int r=0;r<16;++r)o[d_][r]*=wsf[crow(r,hi)]; } }while(0)
  f32x16 pA0,pA1,pB0,pB1;
  int sl_prev=0,sl_cur=0,sl_next=SLOTB;
  #define ROT() do{sl_prev=sl_cur;sl_cur=sl_next;sl_next=(sl_next==(NSLOT-1)*SLOTB)?0:sl_next+SLOTB;}while(0)
  DMA_K(2,2*SLOTB);
  WAIT_BAR(3);
  qkt(pA0,pA1,Kbase,qr,negm,r32,hi);asm volatile("s_nop 15\n\ts_nop 7":"+v"(pA0),"+v"(pA1));CMASK(pA0,pA1,0);
  START(pA0,pA1);
  _Pragma("unroll") for(int r=0;r<16;++r)pA1[r]=__builtin_amdgcn_exp2f(pA1[r]);
  WAIT_BAR(0);
  DMA_K(3,0);DMA_V(1,SLOTB);
  ROT();
  kload8(kf,kp0+sl_cur);
  WAIT_BAR(2);
  s16x4 vlo[8],vhi[8]; u32x4 pw0,pw1,pw2,pw3;
  #define PKW(P,B) cvtpk_s(P[B],P[B+1])
  #define PAF(k) __builtin_bit_cast(bf16x8,pw##k)
  #define VFR(i) (bf16x8){vlo[i][0],vlo[i][1],vlo[i][2],vlo[i][3],vhi[i][0],vhi[i][1],vhi[i][2],vhi[i][3]}
  #define PIN(x) asm volatile("":"+v"(x))
  #define MX3(a,b,c) __builtin_fmaxf(__builtin_fmaxf((a),(b)),(c))
  #define GAPA(MF,A0,A1,A2,A3,W0,W1,PW) do{ MF; sacc+=A0; sacc+=A1; sacc+=A2; sacc+=A3; PIN(sacc); W0; W1; PIN(PW); SBAR(); }while(0)
  #define EX(v) __builtin_amdgcn_exp2f(v)
  #define GAPB(MF,X,B) do{ MF; X[B]=EX(X[B]); X[B+1]=EX(X[B+1]); X[B+2]=EX(X[B+2]); X[B+3]=EX(X[B+3]); PIN(X); SBAR(); }while(0)
  #define VRD(i) do{ vlo[i]=vtr(vp_+(((i)>>2)*4096+((i)&3)*1024)); vhi[i]=vtr(vp_+(((i)>>2)*4096+((i)&3)*1024+512)); }while(0)
  #define KRD(G,j) do{ if(G){ kload2(kf,kp0+sl_next,j); SBAR(); } }while(0)
  #define STEP(C0,C1,P0,P1,t,GK,GV,GL) do{ SBAR(); \
    const lds_cptr vp_=vp0+sl_prev; \
    VRD(0); SBAR(); float sacc=(P0[0]+P0[1]); \
    GAPA(C0=__builtin_amdgcn_mfma_f32_32x32x16_bf16(kf[0],qr[0],negm,0,0,0), P0[2],P0[3],P0[4],P0[5],     pw0[0]=PKW(P0,0), pw0[1]=PKW(P0,2), pw0); \
    VRD(4); SBAR(); GAPA(C1=__builtin_amdgcn_mfma_f32_32x32x16_bf16(kf[1],qr[0],negm,0,0,0), P0[6],P0[7],P0[8],P0[9],     pw0[2]=PKW(P0,4), pw0[3]=PKW(P0,6), pw0); \
    VRD(1); SBAR(); GAPA(C0=__builtin_amdgcn_mfma_f32_32x32x16_bf16(kf[2],qr[1],C0,0,0,0),   P0[10],P0[11],P0[12],P0[13], pw1[0]=PKW(P0,8), pw1[1]=PKW(P0,10), pw1); \
    VRD(5); SBAR(); GAPA(C1=__builtin_amdgcn_mfma_f32_32x32x16_bf16(kf[3],qr[1],C1,0,0,0),   P0[14],P0[15],P1[0],P1[1],   pw1[2]=PKW(P0,12),pw1[3]=PKW(P0,14), pw1); \
    VRD(2); SBAR(); GAPA(C0=__builtin_amdgcn_mfma_f32_32x32x16_bf16(kf[4],qr[2],C0,0,0,0),   P1[2],P1[3],P1[4],P1[5],     pw2[0]=PKW(P1,0), pw2[1]=PKW(P1,2), pw2); \
    VRD(6); SBAR(); GAPA(C1=__builtin_amdgcn_mfma_f32_32x32x16_bf16(kf[5],qr[2],C1,0,0,0),   P1[6],P1[7],P1[8],P1[9],     pw2[2]=PKW(P1,4), pw2[3]=PKW(P1,6), pw2); \
    VRD(3); SBAR(); GAPA(C0=__builtin_amdgcn_mfma_f32_32x32x16_bf16(kf[6],qr[3],C0,0,0,0),   P1[10],P1[11],P1[12],P1[13], pw3[0]=PKW(P1,8), pw3[1]=PKW(P1,10), pw3); \
    VRD(7); SBAR(); GAPA(C1=__builtin_amdgcn_mfma_f32_32x32x16_bf16(kf[7],qr[3],C1,0,0,0),   P1[14],P1[15],0.f,0.f,       pw3[2]=PKW(P1,12),pw3[3]=PKW(P1,14), pw3); \
    l_reg+=sacc; \
    if(GK){DMA_K((t)+3,sl_cur);} if(GV){DMA_V((t)+1,sl_next);} \
    CMASK(C0,C1,t); \
    { float a=MX3(C0[0],C0[1],C1[0]),b=MX3(C0[2],C0[3],C1[1]); a=MX3(a,C1[2],C1[3]); \
      _Pragma("unroll") for(int r=4;r<16;r+=4){a=MX3(a,C0[r],C0[r+1]);b=MX3(b,C0[r+2],C0[r+3]);a=MX3(a,C1[r],C1[r+1]);b=MX3(b,C1[r+2],C1[r+3]);} \
      float rm=__builtin_fmaxf(a,b); { auto rr=__builtin_amdgcn_permlane32_swap(__float_as_uint(rm),__float_as_uint(rm),false,false); rm=__builtin_fmaxf(__uint_as_float(rr[0]),__uint_as_float(rr[1])); } \
      resc=false; \
      if(__builtin_expect(__any(rm>(float)THRL),0)){ const float dl=__builtin_fmaxf(rm,0.f); mhat+=dl; \
        _Pragma("unroll") for(int r=0;r<16;++r){C0[r]-=dl;C1[r]-=dl;} \
        _Pragma("unroll") for(int r=0;r<16;++r)negm[r]=-mhat; asm volatile("":"+v"(negm)); \
        const float f=__builtin_amdgcn_exp2f(-dl); l_reg*=f; if(hi==0)wsf[r32]=f; resc=true; } } \
    SBAR(); \
    GAPB(o[0]=__builtin_amdgcn_mfma_f32_32x32x16_bf16(PAF(0),VFR(0),o[0],0,0,0), C0,0); \
    GAPB(o[1]=__builtin_amdgcn_mfma_f32_32x32x16_bf16(PAF(0),VFR(4),o[1],0,0,0), C0,4); \
    KRD(GL,0); GAPB(o[0]=__builtin_amdgcn_mfma_f32_32x32x16_bf16(PAF(1),VFR(1),o[0],0,0,0), C0,8); \
    KRD(GL,1); GAPB(o[1]=__builtin_amdgcn_mfma_f32_32x32x16_bf16(PAF(1),VFR(5),o[1],0,0,0), C0,12); \
    KRD(GL,2); GAPB(o[0]=__builtin_amdgcn_mfma_f32_32x32x16_bf16(PAF(2),VFR(2),o[0],0,0,0), C1,0); \
    KRD(GL,3); GAPB(o[1]=__builtin_amdgcn_mfma_f32_32x32x16_bf16(PAF(2),VFR(6),o[1],0,0,0), C1,4); \
    GAPB(o[0]=__builtin_amdgcn_mfma_f32_32x32x16_bf16(PAF(3),VFR(3),o[0],0,0,0), C1,8); \
    GAPB(o[1]=__builtin_amdgcn_mfma_f32_32x32x16_bf16(PAF(3),VFR(7),o[1],0,0,0), C1,12); \
    }while(0)
  int t=1;
  #undef CMASK
  #define CMASK(P0,P1,t) do{}while(0)
  for(;t+5<NT;t+=2){
    STEP(pB0,pB1,pA0,pA1,t,true,true,true);     WAIT_BAR(2); RESC(); ROT();
    STEP(pA0,pA1,pB0,pB1,t+1,true,true,true);   WAIT_BAR(2); RESC(); ROT();
  }
  #undef CMASK
  #define CMASK(P0,P1,t) do{}while(0)
  #define ENDW(tt) do{ if((tt)+3<NT){WAIT_BAR(2);} else if((tt)+2<NT){WAIT_BAR(1);} else {WAIT_BAR(0);} }while(0)
  for(;t+1<NT;t+=2){
    STEP(pB0,pB1,pA0,pA1,t,(t+3<NT),(t+1<NT),(t+1<NT));       ENDW(t);   RESC(); ROT();
    STEP(pA0,pA1,pB0,pB1,t+1,(t+4<NT),(t+2<NT),(t+2<NT));     ENDW(t+1); RESC(); ROT();
  }
  STEP(pB0,pB1,pA0,pA1,NT-1,false,false,false); RESC();
  { float sacc=pB0[0]+pB0[1]; _Pragma("unroll") for(int r=2;r<16;++r)sacc+=pB0[r]; _Pragma("unroll") for(int r=0;r<16;++r)sacc+=pB1[r]; l_reg+=sacc;
    pw0=(u32x4){PKW(pB0,0),PKW(pB0,2),PKW(pB0,4),PKW(pB0,6)};pw1=(u32x4){PKW(pB0,8),PKW(pB0,10),PKW(pB0,12),PKW(pB0,14)};pw2=(u32x4){PKW(pB1,0),PKW(pB1,2),PKW(pB1,4),PKW(pB1,6)};pw3=(u32x4){PKW(pB1,8),PKW(pB1,10),PKW(pB1,12),PKW(pB1,14)};
    SBAR(); pv(o,vb0+sl_cur,PAF(0),PAF(1),PAF(2),PAF(3)); }
  #undef PKW
  #undef PAF
  #undef VFR
  #undef PIN
  #undef MX3
  #undef GAPA
  #undef GAPB
  #undef EX
  #undef VRD
  #undef KRD
  #undef STEP
  #undef ENDW
  {auto rr=__builtin_amdgcn_permlane32_swap(__float_as_uint(l_reg),__float_as_uint(l_reg),false,false);l_reg=__uint_as_float(rr[0])+__uint_as_float(rr[1]);}
  if(hi==0)wsf[32+r32]=l_reg;asm volatile("s_waitcnt lgkmcnt(0)":::"memory");
  float rli[16];
  #pragma unroll
  for(int r=0;r<16;++r)rli[r]=__builtin_amdgcn_rcpf(wsf[32+crow(r,hi)]);
  bf16*Ow=Ob+(long)(wid*QBLK)*OP;
  { bf16*stg=(bf16*)(shm+LDS_OST)+wid*2048;
    #pragma unroll
    for(int r=0;r<16;++r){const int orow=crow(r,hi);
      #pragma unroll
      for(int d0=0;d0<2;++d0)stg[orow*64+d0*32+r32]=__float2bfloat16(o[d0][r]*rli[r]);}
    asm volatile("s_waitcnt lgkmcnt(0)":::"memory");
    #pragma unroll
    for(int i=0;i<4;++i){const int row=i*8+(lane>>3),ch=lane&7; const u32x4 v=*(const u32x4*)(stg+row*64+ch*8); ATTN_STORE16(Ow+(long)row*OP+ch*8,v);} }
  asm volatile("s_waitcnt lgkmcnt(0)\n\ts_barrier":::"memory");
  #undef DMA_K
  #undef DMA_V
  #undef CMASK
  #undef START
  #undef RESC
  #undef ROT
}
constexpr int ATTN_LDS_BYTES=LDS_BYTES;
#undef SBAR
#undef WAIT_BAR
}
constexpr int NWAVES = 8;
constexpr int DMODEL = 1024, NBATCH = 8, SEQ = 2048, CTXL = 256, DEPTH = 2;
constexpr int NLAT = NBATCH * SEQ, NCTX = NBATCH * CTXL, MALL = NLAT + NCTX;
constexpr int DFF = 2816, INDIM = 2312, NIN = 2304, P2W = 1792, KVLEN = CTXL + SEQ;
constexpr int NCHUNK = MALL / 128;
constexpr float EPS = 1e-6f;
constexpr float QSCALE = 0.125f * 1.4426950408889634f;
constexpr size_t al256(size_t x) { return (x + 255) & ~(size_t)255; }
constexpr size_t O_CTL = 0, CTL_BYTES = 32768, CTL_PANEL = 16384;
constexpr size_t O_MOD = CTL_BYTES;
constexpr size_t O_DTRAW = O_MOD + al256((size_t)DEPTH * 9 * 6144 * 4);
constexpr size_t O_DTF = O_DTRAW + al256((size_t)MALL * 8 * 4);
constexpr size_t O_DTB = O_DTF + al256((size_t)MALL * 8 * 4);
constexpr size_t O_CD = O_DTB + al256((size_t)MALL * 8 * 4);
constexpr size_t O_W = O_CD + al256((size_t)2 * NCHUNK * 8 * 4);
constexpr size_t WL_IN = 0, WL_OUT = WL_IN + (size_t)NIN * 1024 * 2, WL_GU = WL_OUT + (size_t)1024 * 1024 * 2, WL_D = WL_GU + (size_t)2 * DFF * 1024 * 2, WL_SIZE = WL_D + (size_t)1024 * DFF * 2;
constexpr size_t O_XC = O_W + DEPTH * WL_SIZE;
constexpr size_t O_H = O_XC + (size_t)NCTX * 1024 * 4;
constexpr size_t O_P2 = O_H + (size_t)MALL * 1024 * 2;
constexpr size_t O_Y = O_P2 + (size_t)MALL * P2W * 2;
constexpr size_t O_KN = O_Y + (size_t)MALL * 1024 * 2;
constexpr size_t O_VN = O_KN + (size_t)NBATCH * KVLEN * 128 * 2;
constexpr size_t O_XT = O_VN + (size_t)NBATCH * KVLEN * 128 * 2;
constexpr size_t O_BT = O_XT + (size_t)512 * MALL * 2;
constexpr size_t O_BM = O_BT + (size_t)256 * MALL * 2;
constexpr size_t O_CM = O_BM + (size_t)MALL * 256 * 2;
constexpr size_t O_END = O_CM + (size_t)MALL * 256 * 2;
constexpr size_t O_XS = O_END;
constexpr size_t O_END2 = O_XS + (size_t)NLAT * 4 * 4;
constexpr size_t O_ACT = O_P2;
static_assert(O_ACT + (size_t)MALL * DFF * 2 <= O_KN, "ACT overlay");
static_assert(O_END2 <= ((size_t)256 << 20), "workspace");
static_assert((size_t)2 * NCHUNK * 8 * 64 * 128 * 2 <= (size_t)MALL * 1024 * 2, "S overlay");
constexpr int LDS_BYTES = 147456, RING_BYTES = 131072;

typedef unsigned short bf16;
typedef unsigned v4u __attribute__((ext_vector_type(4)));
typedef unsigned v2u __attribute__((ext_vector_type(2)));
typedef float f32x4 __attribute__((ext_vector_type(4)));
typedef float f32x16 __attribute__((ext_vector_type(16)));
typedef short bf16x8 __attribute__((ext_vector_type(8)));
typedef short s16x4 __attribute__((ext_vector_type(4)));

__device__ __forceinline__ unsigned f2bf(float f) { unsigned u = __builtin_bit_cast(unsigned, f); return (u + 0x7fffu + ((u >> 16) & 1u)) >> 16; }
typedef float f32x2_k __attribute__((ext_vector_type(2))); typedef __bf16 bf16x2_k __attribute__((ext_vector_type(2)));
__device__ __forceinline__ unsigned pk2(float lo, float hi) { f32x2_k v = {lo, hi}; bf16x2_k b = __builtin_convertvector(v, bf16x2_k); return __builtin_bit_cast(unsigned, b); }
__device__ __forceinline__ float sigm(float z) { return __builtin_amdgcn_rcpf(1.0f + __expf(-z)); }
__device__ __forceinline__ float bflo(unsigned w) { return __builtin_bit_cast(float, w << 16); }
__device__ __forceinline__ float bfhi(unsigned w) { return __builtin_bit_cast(float, w & 0xffff0000u); }
__device__ __forceinline__ float bf1(bf16 v) { return __builtin_bit_cast(float, (unsigned)v << 16); }
__device__ __forceinline__ float wave_sum(float v) {
#pragma unroll
    for (int o = 1; o < 64; o <<= 1) v += __shfl_xor(v, o);
    return v;
}
template <int CTRL, int RM> __device__ __forceinline__ float dpp_addf(float v) { const int o = __builtin_amdgcn_update_dpp(0, __builtin_bit_cast(int, v), CTRL, RM, 0xf, false); return v + __builtin_bit_cast(float, o); }
__device__ __forceinline__ float dpp_sum32_last(float v) { v = dpp_addf<0xb1, 0xf>(v); v = dpp_addf<0x4e, 0xf>(v); v = dpp_addf<0x114, 0xf>(v); v = dpp_addf<0x118, 0xf>(v); v = dpp_addf<0x142, 0xa>(v); return v; }
#ifndef OLDSUM
#define OLDSUM 0
#endif
__device__ __forceinline__ float wave_sum_fast(float v) { if (OLDSUM) return wave_sum(v); v = dpp_sum32_last(v); v = dpp_addf<0x143, 0xc>(v); return __builtin_bit_cast(float, __builtin_amdgcn_readlane(__builtin_bit_cast(int, v), 63)); }
__device__ __forceinline__ float dpp_sum8_all(float v) { v = dpp_addf<0xb1, 0xf>(v); v = dpp_addf<0x4e, 0xf>(v); v = dpp_addf<0x141, 0xf>(v); return v; }
__device__ __forceinline__ float dpp_sum16_all(float v) { v = dpp_sum8_all(v); v = dpp_addf<0x140, 0xf>(v); return v; }
__device__ __forceinline__ float wave_incl_scan(float v, int lane) {
#pragma unroll
    for (int o = 1; o < 64; o <<= 1) { const float t = __shfl_up(v, o); if (lane >= o) v += t; }
    return v;
}
__device__ __forceinline__ int crow16(int r, int hi) { return (r & 3) + 8 * (r >> 2) + 4 * hi; }
#define MFMA32(a, b, c) __builtin_amdgcn_mfma_f32_32x32x16_bf16((a), (b), (c), 0, 0, 0)

#define LAS __attribute__((address_space(3)))
#define XB_TMO      128
#define XB_XCNT(j)  (256  + 64 * (j))
#define XB_XSUB(j)  (1280 + 64 * (j))
#define XB_XGEN(j)  (2304 + 64 * (j))
#define XB_TOP      3328
#define XB_TOPGEN   3392
#define XCD_BAR_WORDS 3456
#define XB_SPIN_CAP (1u << 18)

__device__ __forceinline__ unsigned xb_ld(unsigned* p)              { return __hip_atomic_load(p, __ATOMIC_RELAXED, __HIP_MEMORY_SCOPE_AGENT); }
__device__ __forceinline__ unsigned xb_add(unsigned* p, unsigned v) { return __hip_atomic_fetch_add(p, v, __ATOMIC_RELAXED, __HIP_MEMORY_SCOPE_AGENT); }
__device__ __forceinline__ unsigned xb_xcc_id() { return (unsigned)__builtin_amdgcn_s_getreg((3 << 11) | 20) & 0xFu; }
#define XB_SPIN(cond, bar) do { unsigned _sp = 0; while (cond) { __builtin_amdgcn_s_sleep(1); \
    if ((++_sp & 255u) == 0u) { if (xb_ld(&(bar)[XB_TMO])) break; if (_sp > XB_SPIN_CAP) { atomicAdd(&(bar)[XB_TMO], 1u); break; } } } } while (0)

struct XcdBarrier {
    unsigned* bar; unsigned x;
    volatile LAS unsigned* st;
};

__device__ __forceinline__ XcdBarrier xcd_barrier_post(unsigned* bar, volatile LAS unsigned* st) {
    XcdBarrier b; b.bar = bar; b.x = xb_xcc_id(); b.st = st;
    if (threadIdx.x == 0) (void)xb_add(&bar[XB_XCNT(b.x)], 1u);
    return b;
}
__device__ __forceinline__ void xcd_barrier_complete(unsigned* bar, unsigned x, unsigned& nloc, unsigned& nx) {
    const unsigned G = gridDim.x * gridDim.y * gridDim.z;
    unsigned sum, cnt, mine, sp = 0u;
    for (;;) {
        sum = 0u; cnt = 0u; mine = 0u;
#pragma unroll
        for (unsigned j = 0; j < 16; ++j) { const unsigned c = xb_ld(&bar[XB_XCNT(j)]); sum += c; cnt += (c > 0u) ? 1u : 0u; mine = (j == x) ? c : mine; }
        if (sum == G) break;
        __builtin_amdgcn_s_sleep(1);
        if ((++sp & 255u) == 0u) { if (xb_ld(&bar[XB_TMO])) break; if (sp > XB_SPIN_CAP) { atomicAdd(&bar[XB_TMO], 1u); break; } }
    }
    nloc = mine > 0u ? mine : 1u; nx = cnt > 0u ? cnt : 1u;
}

__device__ __forceinline__ void xcd_barrier(const XcdBarrier& b) {
    asm volatile("s_waitcnt vmcnt(0)" ::: "memory");
    __syncthreads();
    if (threadIdx.x == 0) {
        unsigned* bar = b.bar;
        __builtin_amdgcn_s_waitcnt(0);
        unsigned nloc = b.st[0], nx = b.st[1];
        if (nloc == 0u) { xcd_barrier_complete(bar, b.x, nloc, nx); b.st[0] = nloc; b.st[1] = nx; }
        const unsigned old = xb_add(&bar[XB_XSUB(b.x)], 1u);
        const unsigned gen = old / nloc;
        if (old + 1u == (gen + 1u) * nloc) {
            __builtin_amdgcn_fence(__ATOMIC_RELEASE, "agent");
            asm volatile("s_waitcnt vmcnt(0)" ::: "memory");
            const unsigned og = xb_add(&bar[XB_TOP], 1u);
            const unsigned tg = og / nx;
            if (og + 1u == (tg + 1u) * nx) xb_add(&bar[XB_TOPGEN], 1u);
            else XB_SPIN(xb_ld(&bar[XB_TOPGEN]) == tg, bar);
            __builtin_amdgcn_fence(__ATOMIC_ACQUIRE, "agent");
            xb_add(&bar[XB_XGEN(b.x)], 1u);
            asm volatile("s_waitcnt vmcnt(0)" ::: "memory");
        } else {
            XB_SPIN(xb_ld(&bar[XB_XGEN(b.x)]) == gen, bar);
            __builtin_amdgcn_fence(__ATOMIC_ACQUIRE, "agent");
            asm volatile("s_waitcnt vmcnt(0)" ::: "memory");
        }
    }
    __syncthreads();
}

struct Args { const float* in[25]; float* out; unsigned char* ws; };
typedef const __attribute__((address_space(4))) Args* kargp_t;
struct Frame {
    unsigned char* lds; int tid, lane, wave, G, bid;
    kargp_t ap; float* out; unsigned char* ws;
    __device__ __forceinline__ const float* inp(int i) const { kargp_t p = ap; asm volatile("" : "+s"(p)); return (const float*)(const __attribute__((address_space(1))) float*)p->in[i]; }
    __device__ __forceinline__ void fresh() { int t = threadIdx.x; asm volatile("" : "+v"(t)); tid = t; lane = t & 63; wave = __builtin_amdgcn_readfirstlane(t >> 6); }
    __device__ __forceinline__ unsigned char* wsp() const { __attribute__((address_space(1))) unsigned char* p = (__attribute__((address_space(1))) unsigned char*)ws; asm volatile("" : "+s"(p)); return (unsigned char*)p; }
    __device__ __forceinline__ float* outp() const { __attribute__((address_space(1))) float* p = (__attribute__((address_space(1))) float*)out; asm volatile("" : "+s"(p)); return (float*)p; }
};
__device__ __forceinline__ int gu_row(int a) { return 256 * (a >> 7) + (a & 127); }
__device__ __forceinline__ void transpose_item(const float* W, int ldw, int K, int N, bf16* WT, int mode, float* scr, int item, int lane) {
    const int nblk = N / 32, kb = item / nblk, nb = item % nblk, k0 = 64 * kb, n0 = 32 * nb;
#pragma unroll 8
    for (int i = 0; i < 32; ++i) { const int kk = 2 * i + (lane >> 5); scr[kk * 33 + (lane & 31)] = __builtin_nontemporal_load(W + (size_t)(k0 + kk) * ldw + n0 + (lane & 31)); }
    __builtin_amdgcn_s_waitcnt(0xc07f); asm volatile("s_waitcnt lgkmcnt(0)" ::: "memory");
    const int c = lane & 7;
#pragma unroll
    for (int j = 0; j < 4; ++j) { const int n = (lane >> 3) + 8 * j; const float* s = scr + (8 * c) * 33 + n;
        v4u o; o.x = pk2(s[0 * 33], s[1 * 33]); o.y = pk2(s[2 * 33], s[3 * 33]); o.z = pk2(s[4 * 33], s[5 * 33]); o.w = pk2(s[6 * 33], s[7 * 33]);
        const int a = n0 + n; const int drow = mode == 0 ? a : gu_row(a) + (mode == 2 ? 128 : 0);
        *(v4u*)(WT + (size_t)drow * K + k0 + 8 * c) = o; }
    asm volatile("s_waitcnt lgkmcnt(0)" ::: "memory");
}
__device__ __forceinline__ void phase_prologue(Frame& F) {
    F.fresh();
    __syncthreads();
    float* ldsf = (float*)F.lds;
    if (F.bid < 192) {
        const int lyr = F.bid / 96, n0 = (F.bid % 96) * 64;
        float* sc = ldsf;
        float* red = ldsf + 9 * 1024;
        for (int i = F.tid; i < 9 * 1024; i += 512) { const int s = i >> 10, k = i & 1023; const float v = s < 8 ? F.inp(1)[s * 1024 + k] : F.inp(3)[k]; sc[i] = v / (1.0f + __expf(-v)); }
        __syncthreads();
        const int col = F.tid & 63, ks = F.tid >> 6;
        float acc[9];
#pragma unroll
        for (int s = 0; s < 9; ++s) acc[s] = 0.f;
        const float* wp = F.inp(4) + (size_t)lyr * 1024 * 6144 + (size_t)(ks * 128) * 6144 + n0 + col;
#pragma unroll 8
        for (int k = 0; k < 128; ++k) { const float w = __builtin_nontemporal_load(wp + (size_t)k * 6144);
#pragma unroll
            for (int s = 0; s < 9; ++s) acc[s] += sc[s * 1024 + ks * 128 + k] * w; }
#pragma unroll
        for (int s = 0; s < 9; ++s) red[(ks * 9 + s) * 64 + col] = acc[s];
        __syncthreads();
        float* MOD = (float*)(F.wsp() + O_MOD);
        for (int i = F.tid; i < 9 * 64; i += 512) { const int s = i >> 6, c2 = i & 63; float v = F.inp(5)[lyr * 6144 + n0 + c2];
#pragma unroll
            for (int q = 0; q < 8; ++q) v += red[(q * 9 + s) * 64 + c2];
            MOD[((size_t)lyr * 9 + s) * 6144 + n0 + c2] = v; }
        __syncthreads();
    }
    float* scr = ldsf + F.wave * 4096;
    const int gw = F.bid * NWAVES + F.wave, NGW = F.G * NWAVES;
    constexpr int I_IN = 16 * (NIN / 32), I_OUT = 16 * 32, I_G = 16 * (DFF / 32), I_D = (DFF / 64) * 32, I_L = I_IN + I_OUT + 2 * I_G + I_D;
    for (int it = gw; it < DEPTH * I_L; it += NGW) {
        const int l = it / I_L; int r = it % I_L; bf16* wl = (bf16*)(F.wsp() + O_W + (size_t)l * WL_SIZE);
        if (r < I_IN) { transpose_item(F.inp(10) + (size_t)l * 1024 * INDIM, INDIM, 1024, NIN, wl + WL_IN / 2, 0, scr, r, F.lane); continue; } r -= I_IN;
        if (r < I_OUT) { transpose_item(F.inp(21) + (size_t)l * 1024 * 1024, 1024, 1024, 1024, wl + WL_OUT / 2, 0, scr, r, F.lane); continue; } r -= I_OUT;
        if (r < I_G) { transpose_item(F.inp(22) + (size_t)l * 1024 * DFF, DFF, 1024, DFF, wl + WL_GU / 2, 1, scr, r, F.lane); continue; } r -= I_G;
        if (r < I_G) { transpose_item(F.inp(23) + (size_t)l * 1024 * DFF, DFF, 1024, DFF, wl + WL_GU / 2, 2, scr, r, F.lane); continue; } r -= I_G;
        transpose_item(F.inp(24) + (size_t)l * DFF * 1024, 1024, DFF, 1024, wl + WL_D / 2, 0, scr, r, F.lane);
    }
}
__device__ __forceinline__ const float* xsrc_row(Frame& F, bool from_input, int row) {
    if (from_input) return row < NLAT ? F.inp(0) + (size_t)row * 1024 : F.inp(2) + (size_t)(row - NLAT) * 1024;
    return row < NLAT ? F.outp() + (size_t)row * 1024 : (const float*)(F.wsp() + O_XC) + (size_t)(row - NLAT) * 1024;
}
template <bool RESID, bool PRE, bool DT>
__device__ __forceinline__ void phase_rows(Frame& F, int row_lo, int row_hi, int wg_lo, int wg_cnt, bool from_input, int lr, int gidx, int wpost_i, int lp, int shidx, int wpre_i) {
    F.fresh();
    if (F.bid < wg_lo || F.bid >= wg_lo + wg_cnt) return;
    float* wdt = (float*)F.lds;
    if (DT) {
        for (int i = F.tid; i < 1024 * 8; i += 512) wdt[i] = F.inp(10)[(size_t)lp * 1024 * INDIM + (size_t)(i >> 3) * INDIM + NIN + (i & 7)];
        __syncthreads();
    }
    const float* MOD = (const float*)(F.wsp() + O_MOD);
    bf16* H = (bf16*)(F.wsp() + O_H);
    const int gw = (F.bid - wg_lo) * NWAVES + F.wave, NGW = wg_cnt * NWAVES, lane = F.lane;
    const int rpw_full = (row_hi - row_lo + NGW - 1) / NGW;
    f32x4 wpo[4], wpr[4], gm[4], shm_[4], scm[4];
#pragma unroll
    for (int j = 0; j < 4; ++j) { wpo[j] = RESID ? ((const f32x4*)(F.inp(wpost_i) + (size_t)lr * 1024) + lane)[64 * j] : (f32x4){0.f, 0.f, 0.f, 0.f};
        wpr[j] = PRE ? ((const f32x4*)(F.inp(wpre_i) + (size_t)lp * 1024) + lane)[64 * j] : (f32x4){0.f, 0.f, 0.f, 0.f}; gm[j] = shm_[j] = scm[j] = (f32x4){0.f, 0.f, 0.f, 0.f}; }
    int cur_s = -1;
    const int row0 = row_lo + gw * rpw_full;
    const int rpw = row0 >= row_hi ? 0 : (row_hi - row0 < rpw_full ? row_hi - row0 : rpw_full);
    f32x4 v[4], vn[4]; v2u mw[4], mwn[4];
    if (rpw > 0) { const f32x4* xr = (const f32x4*)xsrc_row(F, from_input, row0) + lane;
#pragma unroll
      for (int j = 0; j < 4; ++j) { vn[j] = __builtin_nontemporal_load(xr + 64 * j); if (RESID) mwn[j] = __builtin_nontemporal_load((const v2u*)(H + (size_t)row0 * 1024) + lane + 64 * j); } }
    for (int k = 0; k < rpw; ++k) {
        const int row = row0 + k;
        const int s = row < NLAT ? row / SEQ : 8;
#pragma unroll
        for (int j = 0; j < 4; ++j) { v[j] = vn[j]; if (RESID) mw[j] = mwn[j]; }
        if (k + 1 < rpw) { const f32x4* xr = (const f32x4*)xsrc_row(F, from_input, row + 1) + lane;
#pragma unroll
            for (int j = 0; j < 4; ++j) { vn[j] = __builtin_nontemporal_load(xr + 64 * j); if (RESID) mwn[j] = __builtin_nontemporal_load((const v2u*)(H + (size_t)(row + 1) * 1024) + lane + 64 * j); } }
        if (s != cur_s) { cur_s = s;
#pragma unroll
            for (int j = 0; j < 4; ++j) {
                if (RESID) gm[j] = ((const f32x4*)(MOD + ((size_t)lr * 9 + s) * 6144 + gidx * 1024) + lane)[64 * j];
                if (PRE) { shm_[j] = ((const f32x4*)(MOD + ((size_t)lp * 9 + s) * 6144 + shidx * 1024) + lane)[64 * j]; scm[j] = ((const f32x4*)(MOD + ((size_t)lp * 9 + s) * 6144 + (shidx + 1) * 1024) + lane)[64 * j]; } } }
        if (RESID) {
            f32x4 m[4]; float ss = 0.f;
#pragma unroll
            for (int j = 0; j < 4; ++j) { const v2u w = mw[j]; m[j] = (f32x4){bflo(w.x), bfhi(w.x), bflo(w.y), bfhi(w.y)}; ss += (m[j].x * m[j].x + m[j].y * m[j].y) + (m[j].z * m[j].z + m[j].w * m[j].w); }
            const float rstd = 1.0f / sqrtf(wave_sum_fast(ss) * (1.0f / 1024.0f) + EPS);
            float* xo = (row < NLAT ? F.outp() + (size_t)row * 1024 : (float*)(F.wsp() + O_XC) + (size_t)(row - NLAT) * 1024);
#pragma unroll
            for (int j = 0; j < 4; ++j) { v[j] = v[j] + gm[j] * (m[j] * rstd * wpo[j]); __builtin_nontemporal_store(v[j], (f32x4*)xo + lane + 64 * j); }
        }
        if (PRE) {
            float ss = 0.f;
#pragma unroll
            for (int j = 0; j < 4; ++j) ss += (v[j].x * v[j].x + v[j].y * v[j].y) + (v[j].z * v[j].z + v[j].w * v[j].w);
            const float rstd = 1.0f / sqrtf(wave_sum_fast(ss) * (1.0f / 1024.0f) + EPS);
            float dacc[8];
#pragma unroll
            for (int e = 0; e < 8; ++e) dacc[e] = 0.f;
            v2u* ho = (v2u*)(H + (size_t)row * 1024) + lane;
#pragma unroll
            for (int j = 0; j < 4; ++j) {
                const f32x4 h = (v[j] * rstd * wpr[j]) * (scm[j] + 1.0f) + shm_[j];
                v2u o; o.x = pk2(h.x, h.y); o.y = pk2(h.z, h.w); ho[64 * j] = o;
                if (DT) {
#pragma unroll
                    for (int e = 0; e < 4; ++e) { const f32x4* wk = (const f32x4*)(wdt + (size_t)(4 * lane + 256 * j + e) * 8); const f32x4 w0 = wk[0], w1 = wk[1];
                        dacc[0] += h[e] * w0.x; dacc[1] += h[e] * w0.y; dacc[2] += h[e] * w0.z; dacc[3] += h[e] * w0.w; dacc[4] += h[e] * w1.x; dacc[5] += h[e] * w1.y; dacc[6] += h[e] * w1.z; dacc[7] += h[e] * w1.w; } }
            }
            if (DT) {
                float r4[4];
#pragma unroll
                for (int e = 0; e < 4; ++e) { const float keep = lane < 32 ? dacc[e] : dacc[e + 4], send = lane < 32 ? dacc[e + 4] : dacc[e];
                    r4[e] = dpp_sum32_last(keep + __shfl_xor(send, 32)); }
                if ((lane & 31) == 31) { float* dr = (float*)(F.wsp() + O_DTRAW) + (size_t)row * 8 + (lane >> 5) * 4; *(f32x4*)dr = (f32x4){r4[0], r4[1], r4[2], r4[3]}; }
            }
        }
    }
    if (DT) __syncthreads();
}
__device__ __forceinline__ void qk_norm_rope(const v2u a1, const v2u a2, const float* nw, int d0, bool rope, int t, float scale, v2u& o1, v2u& o2) {
    float x1[4] = {bflo(a1.x), bfhi(a1.x), bflo(a1.y), bfhi(a1.y)}, x2[4] = {bflo(a2.x), bfhi(a2.x), bflo(a2.y), bfhi(a2.y)};
    float ss = 0.f;
#pragma unroll
    for (int e = 0; e < 4; ++e) ss += x1[e] * x1[e] + x2[e] * x2[e];
    ss = dpp_sum8_all(ss);
    const float rstd = 1.0f / sqrtf(ss * (1.0f / 64.0f) + EPS);
    float r1[4], r2[4];
#pragma unroll
    for (int e = 0; e < 4; ++e) {
        const float y1 = x1[e] * rstd * nw[d0 + e], y2 = x2[e] * rstd * nw[32 + d0 + e];
        if (rope) {
            const int i = d0 + e;
            const float pos = (float)(i < 16 ? (t >> 6) : (t & 63));
            const float freq = exp2f(-(float)(i & 15) * (13.287712379549449f / 16.0f));
            const float ang = pos * freq;
            float rev = ang * 0.15915494309189535f; rev = rev - floorf(rev);
            const float sn = __builtin_amdgcn_sinf(rev), cs = __builtin_amdgcn_cosf(rev);
            r1[e] = (y1 * cs - y2 * sn) * scale; r2[e] = (y1 * sn + y2 * cs) * scale;
        } else { r1[e] = y1 * scale; r2[e] = y2 * scale; }
    }
    o1.x = pk2(r1[0], r1[1]); o1.y = pk2(r1[2], r1[3]); o2.x = pk2(r2[0], r2[1]); o2.y = pk2(r2[2], r2[3]);
}
__device__ __forceinline__ void phase_post(Frame& F, int l) {
    F.fresh();
    bf16* Y = (bf16*)(F.wsp() + O_Y); const bf16* P2 = (const bf16*)(F.wsp() + O_P2);
    bf16* KN = (bf16*)(F.wsp() + O_KN); bf16* VN = (bf16*)(F.wsp() + O_VN);
    const int gw = F.bid * NWAVES + F.wave, NGW = F.G * NWAVES, lane = F.lane;
    const float* qn = F.inp(11) + l * 64; const float* kn = F.inp(12) + l * 64;
    const int hd = lane >> 3, d0 = (lane & 7) * 4, hk = hd & 1;
    const float* DTR = (const float*)(F.wsp() + O_DTRAW);
    struct PostIn { v2u q1, q2, k1, k2; v4u v; float dt; };
#define POST_LOAD(P, row_) do { if ((row_) < MALL) { const bf16* qp_ = Y + (size_t)(row_) * 1024 + hd * 64 + d0; P.q1 = *(const v2u*)qp_; P.q2 = *(const v2u*)(qp_ + 32); \
        const bf16* kp_ = P2 + (size_t)(row_) * P2W + hk * 64 + d0; P.k1 = __builtin_nontemporal_load((const v2u*)kp_); P.k2 = __builtin_nontemporal_load((const v2u*)(kp_ + 32)); \
        P.v = __builtin_nontemporal_load((const v4u*)(P2 + (size_t)(row_) * P2W + 128 + (lane & 15) * 8)); P.dt = DTR[(size_t)(row_) * 8 + (lane & 7)]; } } while (0)
#define POST_ROW(P, row_) do { if ((row_) < MALL) { const int rw_ = (row_); const bool lat = rw_ < NLAT; int b, t, pos; \
        if (lat) { b = rw_ >> 11; t = rw_ & 2047; pos = CTXL + t; } else { const int rr = rw_ - NLAT; b = rr >> 8; t = rr & 255; pos = t; } \
        { v2u o1, o2; qk_norm_rope(P.q1, P.q2, qn, d0, lat, t, QSCALE, o1, o2); bf16* qp = Y + (size_t)rw_ * 1024 + hd * 64 + d0; *(v2u*)qp = o1; *(v2u*)(qp + 32) = o2; } \
        { v2u o1, o2; qk_norm_rope(P.k1, P.k2, kn, d0, lat, t, 1.0f, o1, o2); \
          if (lane < 16) { bf16* ko = KN + ((size_t)b * KVLEN + pos) * 128 + hk * 64 + d0; *(v2u*)ko = o1; *(v2u*)(ko + 32) = o2; } } \
        if (lane >= 16 && lane < 32) *(v4u*)(VN + ((size_t)b * KVLEN + pos) * 128 + (lane - 16) * 8) = P.v; \
        if (lane >= 32 && lane < 48) { const int jj = lane - 32, hh = jj & 7, dir = jj >> 3; \
            const float raw = P.dt + F.inp(dir ? 16 : 15)[l * 8 + hh]; \
            const float sp = raw > 20.f ? raw : log1pf(expf(raw)); \
            ((float*)(F.wsp() + (dir ? O_DTB : O_DTF)))[(size_t)rw_ * 8 + hh] = sp; } } } while (0)
    bf16* XT = (bf16*)(F.wsp() + O_XT); bf16* BT = (bf16*)(F.wsp() + O_BT); bf16* BMp = (bf16*)(F.wsp() + O_BM); bf16* CMp = (bf16*)(F.wsp() + O_CM);
    const float* cw = F.inp(13) + (size_t)l * 5 * 1024; const float* cb = F.inp(14) + (size_t)l * 1024;
    const int ch = 8 * (F.tid & 127), sub = F.tid >> 7;
    float wv[5][8], bv[8];
#pragma unroll
    for (int k = 0; k < 5; ++k) { const f32x4 a = *(const f32x4*)(cw + k * 1024 + ch), b = *(const f32x4*)(cw + k * 1024 + ch + 4);
#pragma unroll
        for (int e = 0; e < 4; ++e) { wv[k][e] = a[e]; wv[k][4 + e] = b[e]; } }
    { const f32x4 a = *(const f32x4*)(cb + ch), b = *(const f32x4*)(cb + ch + 4);
#pragma unroll
      for (int e = 0; e < 4; ++e) { bv[e] = a[e]; bv[4 + e] = b[e]; } }
    PostIn p0, p1, p2;
    POST_LOAD(p0, gw); POST_LOAD(p1, gw + NGW);
    int arow = gw;
    for (int blk = F.bid; blk < MALL / 32 || arow < MALL; blk += F.G) {
        const bool cv = blk < MALL / 32;
        const int r0 = blk * 32;
        const int seglen = r0 < NLAT ? SEQ : CTXL; const int segbase = r0 < NLAT ? (r0 & ~(SEQ - 1)) : NLAT + ((r0 - NLAT) & ~(CTXL - 1));
        const bool lo_ok = r0 > segbase, hi_ok = r0 + 32 < segbase + seglen;
        const int k0 = 8 * sub;
        v4u un[12];
        if (cv) { const bf16* src = P2 + (size_t)(r0 + k0) * P2W + 768 + ch;
#pragma unroll
            for (int j = 0; j < 12; ++j) { const int kk = k0 - 2 + j; un[j] = ((kk >= 0 || lo_ok) && (kk < 32 || hi_ok)) ? *(const v4u*)(src + (ptrdiff_t)(j - 2) * P2W) : (v4u){0u, 0u, 0u, 0u}; } }
        else {
#pragma unroll
            for (int j = 0; j < 12; ++j) un[j] = (v4u){0u, 0u, 0u, 0u}; }
        POST_LOAD(p2, arow + 2 * NGW); POST_ROW(p0, arow);
        POST_LOAD(p0, arow + 3 * NGW); POST_ROW(p1, arow + NGW);
        POST_LOAD(p1, arow + 4 * NGW); POST_ROW(p2, arow + 2 * NGW);
        arow += 3 * NGW;
        if (cv) {
            unsigned pk[8][4];
#pragma unroll
            for (int j = 0; j < 8; ++j) {
                float y[8];
#pragma unroll
                for (int e = 0; e < 8; ++e) y[e] = bv[e];
#pragma unroll
                for (int k = 0; k < 5; ++k) { const v4u u = un[j + k]; const unsigned uu[4] = {u.x, u.y, u.z, u.w};
#pragma unroll
                    for (int e = 0; e < 4; ++e) { y[2 * e] += wv[k][2 * e] * bflo(uu[e]); y[2 * e + 1] += wv[k][2 * e + 1] * bfhi(uu[e]); } }
                unsigned o[8];
#pragma unroll
                for (int e = 0; e < 8; ++e) { const float t = y[e] * sigm(y[e]); o[e] = f2bf(t); }
                if (ch >= 512) { const v4u tv = (v4u){o[0] | (o[1] << 16), o[2] | (o[3] << 16), o[4] | (o[5] << 16), o[6] | (o[7] << 16)};
                    bf16* dM = ch < 768 ? BMp + (size_t)(r0 + k0 + j) * 256 + (ch - 512) : CMp + (size_t)(r0 + k0 + j) * 256 + (ch - 768); *(v4u*)dM = tv; }
#pragma unroll
                for (int e = 0; e < 8; ++e) { if (j & 1) pk[e][j >> 1] |= o[e] << 16; else pk[e][j >> 1] = o[e]; }
            }
            if (ch < 768) { bf16* dT = (ch < 512 ? XT + (size_t)ch * MALL : BT + (size_t)(ch - 512) * MALL) + r0 + k0;
#pragma unroll
                for (int e = 0; e < 8; ++e) *(v4u*)(dT + (size_t)e * MALL) = (v4u){pk[e][0], pk[e][1], pk[e][2], pk[e][3]}; }
        }
    }
#undef POST_LOAD
#undef POST_ROW
}
__device__ __forceinline__ void phase_ssd1(Frame& F, int l) {
    F.fresh();
    const int lane = F.lane, tid = F.tid, hl = F.wave & 3, pt = F.wave >> 2, r32 = lane & 31, hi = lane >> 5;
    constexpr int PT = 136;
    bf16* Bs = (bf16*)F.lds; bf16* Xs = Bs + 128 * PT;
    float* wtab = (float*)(F.lds + (128 + 256) * PT * 2) + F.wave * 256;
    const bf16* XT = (const bf16*)(F.wsp() + O_XT); const bf16* BT = (const bf16*)(F.wsp() + O_BT);
    const float* DTF = (const float*)(F.wsp() + O_DTF); const float* DTB = (const float*)(F.wsp() + O_DTB);
    bf16* S = (bf16*)(F.wsp() + O_H); float* CD = (float*)(F.wsp() + O_CD);
    for (int u = F.bid; u < 2 * NCHUNK; u += F.G) {
        const int c = u >> 1, g = u & 1, h = 4 * g + hl;
        const size_t rb = (size_t)c * 128;
        v4u tx[8], tb[4];
#pragma unroll
        for (int q = 0; q < 8; ++q) { const int idx = tid + 512 * q; tx[q] = *(const v4u*)(XT + (size_t)(g * 256 + (idx >> 4)) * MALL + rb + (idx & 15) * 8); }
#pragma unroll
        for (int q = 0; q < 4; ++q) { const int idx = tid + 512 * q; tb[q] = *(const v4u*)(BT + (size_t)(g * 128 + (idx >> 4)) * MALL + rb + (idx & 15) * 8); }
        const float Af = -expf(F.inp(17)[l * 8 + h]), Ab = -expf(F.inp(18)[l * 8 + h]);
        { const float d0 = DTF[(rb + 2 * lane) * 8 + h], d1 = DTF[(rb + 2 * lane + 1) * 8 + h]; const float a0 = d0 * Af, a1 = d1 * Af;
          const float inc = wave_incl_scan(a0 + a1, lane); const float tot = __shfl(inc, 63); const float c1 = inc, c0 = inc - a1;
          wtab[2 * lane] = __expf(tot - c0) * d0; wtab[2 * lane + 1] = __expf(tot - c1) * d1;
          if (lane == 0 && pt == 0) CD[(0 * NCHUNK + c) * 8 + h] = __expf(tot); }
        { const float d0 = DTB[(rb + 2 * lane) * 8 + h], d1 = DTB[(rb + 2 * lane + 1) * 8 + h]; const float a0 = d0 * Ab, a1 = d1 * Ab;
          const float inc = wave_incl_scan(a0 + a1, lane); const float tot = __shfl(inc, 63); const float e0 = inc - a0 - a1, e1 = inc - a1;
          wtab[128 + 2 * lane] = __expf(e0) * d0; wtab[128 + 2 * lane + 1] = __expf(e1) * d1;
          if (lane == 0 && pt == 0) CD[(1 * NCHUNK + c) * 8 + h] = __expf(tot); }
#pragma unroll
        for (int q = 0; q < 8; ++q) { const int idx = tid + 512 * q; *(v4u*)(Xs + (idx >> 4) * PT + (idx & 15) * 8) = tx[q]; }
#pragma unroll
        for (int q = 0; q < 4; ++q) { const int idx = tid + 512 * q; *(v4u*)(Bs + (idx >> 4) * PT + (idx & 15) * 8) = tb[q]; }
        __syncthreads();
        const bf16* xrow = Xs + (64 * hl + 32 * pt + r32) * PT + 8 * hi;
        const bf16* brow = Bs + r32 * PT + 8 * hi;
#pragma unroll 1
        for (int dir = 0; dir < 2; ++dir) {
            f32x16 acc[4];
#pragma unroll
            for (int b = 0; b < 4; ++b)
#pragma unroll
                for (int r = 0; r < 16; ++r) acc[b][r] = 0.f;
#pragma unroll 2
            for (int ks = 0; ks < 8; ++ks) {
                const f32x4 w0 = *(const f32x4*)(wtab + dir * 128 + 16 * ks + 8 * hi), w1 = *(const f32x4*)(wtab + dir * 128 + 16 * ks + 8 * hi + 4);
                const v4u raw = *(const v4u*)(xrow + 16 * ks);
                v4u o; o.x = pk2(bflo(raw.x) * w0.x, bfhi(raw.x) * w0.y); o.y = pk2(bflo(raw.y) * w0.z, bfhi(raw.y) * w0.w); o.z = pk2(bflo(raw.z) * w1.x, bfhi(raw.z) * w1.y); o.w = pk2(bflo(raw.w) * w1.z, bfhi(raw.w) * w1.w);
                const bf16x8 af = __builtin_bit_cast(bf16x8, o);
#pragma unroll
                for (int nt = 0; nt < 4; ++nt) acc[nt] = MFMA32(af, *(const bf16x8*)(brow + 32 * nt * PT + 16 * ks), acc[nt]);
            }
            bf16* so = S + ((size_t)(dir * NCHUNK + c) * 8 + h) * 8192 + (size_t)(32 * pt) * 128 + r32;
#pragma unroll
            for (int nt = 0; nt < 4; ++nt)
#pragma unroll
                for (int r = 0; r < 16; ++r) so[crow16(r, hi) * 128 + 32 * nt] = (bf16)f2bf(acc[nt][r]);
        }
        __syncthreads();
    }
}
__device__ __forceinline__ void phase_ssd2(Frame& F) {
    F.fresh();
    bf16* S = (bf16*)(F.wsp() + O_H); const float* CD = (const float*)(F.wsp() + O_CD);
    for (int gidx = F.bid * 512 + F.tid; gidx < 128 * 1024; gidx += F.G * 512) {
        const int seq = gidx >> 10, e8 = gidx & 1023, b = seq >> 4, dir = (seq >> 3) & 1, h = seq & 7;
        v4u raw[18];
#pragma unroll
        for (int s = 0; s < 18; ++s) { const int c = s < 2 ? 128 + 2 * b + (dir ? 1 - s : s) : 16 * b + (dir ? 17 - s : s - 2);
            raw[s] = __builtin_nontemporal_load((const v4u*)(S + ((size_t)(dir * NCHUNK + c) * 8 + h) * 8192 + e8 * 8)); }
        float st[8];
#pragma unroll
        for (int e = 0; e < 8; ++e) st[e] = 0.f;
#pragma unroll
        for (int s = 0; s < 18; ++s) { const int c = s < 2 ? 128 + 2 * b + (dir ? 1 - s : s) : 16 * b + (dir ? 17 - s : s - 2);
            const float d = CD[(dir * NCHUNK + c) * 8 + h];
            v4u o; o.x = pk2(st[0], st[1]); o.y = pk2(st[2], st[3]); o.z = pk2(st[4], st[5]); o.w = pk2(st[6], st[7]);
            *(v4u*)(S + ((size_t)(dir * NCHUNK + c) * 8 + h) * 8192 + e8 * 8) = o;
            const unsigned u[4] = {raw[s].x, raw[s].y, raw[s].z, raw[s].w};
#pragma unroll
            for (int e = 0; e < 4; ++e) { st[2 * e] = st[2 * e] * d + bflo(u[e]); st[2 * e + 1] = st[2 * e + 1] * d + bfhi(u[e]); } }
    }
}
__device__ __forceinline__ void phase_ssd12(Frame& F, int l) {
    F.fresh();
    if (F.bid >= 128) return;
    const int lane = F.lane, r32 = lane & 31, hi = lane >> 5, pt = F.wave >> 2, nt = F.wave & 3;
    const int b = F.bid >> 4, dir = (F.bid >> 3) & 1, h = F.bid & 7, g = h >> 2;
    float* wtab = (float*)F.lds + F.wave * 128;
    const bf16* XTr = (const bf16*)(F.wsp() + O_XT) + (size_t)(h * 64 + 32 * pt + r32) * MALL + 8 * hi;
    const bf16* BTr = (const bf16*)(F.wsp() + O_BT) + (size_t)(g * 128 + 32 * nt + r32) * MALL + 8 * hi;
    const float* DT = (const float*)(F.wsp() + (dir ? O_DTB : O_DTF)) + h;
    bf16* S = (bf16*)(F.wsp() + O_H);
    const float Aa = -expf(F.inp(dir ? 18 : 17)[l * 8 + h]);
    f32x16 acc;
#pragma unroll
    for (int r = 0; r < 16; ++r) acc[r] = 0.f;
#define S12_CHUNK(s_) ((s_) < 2 ? 128 + 2 * b + (dir ? 1 - (s_) : (s_)) : 16 * b + (dir ? 17 - (s_) : (s_) - 2))
#define S12_LOAD(A_, B_, d0_, d1_, c_) do { const size_t rb_ = (size_t)(c_) * 128; \
        _Pragma("unroll") for (int ks = 0; ks < 8; ++ks) { A_[ks] = *(const v4u*)(XTr + rb_ + 16 * ks); B_[ks] = *(const bf16x8*)(BTr + rb_ + 16 * ks); } \
        d0_ = DT[(rb_ + 2 * lane) * 8]; d1_ = DT[(rb_ + 2 * lane + 1) * 8]; } while (0)
#define S12_STEP(A_, B_, d0_, d1_, c_) do { \
        const float a0 = d0_ * Aa, a1 = d1_ * Aa; const float inc = wave_incl_scan(a0 + a1, lane); const float tot = __shfl(inc, 63); \
        if (dir == 0) { wtab[2 * lane] = __expf(tot - (inc - a1)) * d0_; wtab[2 * lane + 1] = __expf(tot - inc) * d1_; } \
        else { wtab[2 * lane] = __expf(inc - a0 - a1) * d0_; wtab[2 * lane + 1] = __expf(inc - a1) * d1_; } \
        const float dec = __expf(tot); \
        bf16* so = S + ((size_t)(dir * NCHUNK + (c_)) * 8 + h) * 8192 + (size_t)(32 * pt) * 128 + 32 * nt + r32; \
        _Pragma("unroll") for (int r = 0; r < 16; ++r) { so[crow16(r, hi) * 128] = (bf16)f2bf(acc[r]); acc[r] *= dec; } \
        asm volatile("s_waitcnt lgkmcnt(0)" ::: "memory"); \
        _Pragma("unroll") for (int ks = 0; ks < 8; ++ks) { const f32x4 w0 = *(const f32x4*)(wtab + 16 * ks + 8 * hi), w1 = *(const f32x4*)(wtab + 16 * ks + 8 * hi + 4); const v4u raw = A_[ks]; \
            v4u o; o.x = pk2(bflo(raw.x) * w0.x, bfhi(raw.x) * w0.y); o.y = pk2(bflo(raw.y) * w0.z, bfhi(raw.y) * w0.w); o.z = pk2(bflo(raw.z) * w1.x, bfhi(raw.z) * w1.y); o.w = pk2(bflo(raw.w) * w1.z, bfhi(raw.w) * w1.w); \
            acc = MFMA32(__builtin_bit_cast(bf16x8, o), B_[ks], acc); } \
        asm volatile("s_waitcnt lgkmcnt(0)" ::: "memory"); __builtin_amdgcn_sched_barrier(0); } while (0)
    v4u A0[8], A1[8]; bf16x8 B0[8], B1[8]; float e0, e1, f0, f1;
    S12_LOAD(A0, B0, e0, e1, S12_CHUNK(0));
#pragma unroll 1
    for (int sp = 0; sp < 9; ++sp) {
        const int s0 = 2 * sp, c0 = S12_CHUNK(s0), c1 = S12_CHUNK(s0 + 1), s2 = s0 + 2 < 18 ? s0 + 2 : 17, c2 = S12_CHUNK(s2);
        S12_LOAD(A1, B1, f0, f1, c1);
        S12_STEP(A0, B0, e0, e1, c0);
        S12_LOAD(A0, B0, e0, e1, c2);
        S12_STEP(A1, B1, f0, f1, c1);
    }
#undef S12_CHUNK
#undef S12_LOAD
#undef S12_STEP
}
__device__ __forceinline__ void ssd3_unit(Frame& F, int l, int c) {
    F.fresh();
    const int lane = F.lane, h = F.wave, g = h >> 2, r32 = lane & 31, hi = lane >> 5;
    float* tab = (float*)F.lds + h * 512;
    float* ssqb = (float*)F.lds + 8 * 512;
    const bf16* XT = (const bf16*)(F.wsp() + O_XT); const bf16* BMp = (const bf16*)(F.wsp() + O_BM); const bf16* CMp = (const bf16*)(F.wsp() + O_CM);
    const bf16* P2 = (const bf16*)(F.wsp() + O_P2); bf16* Y = (bf16*)(F.wsp() + O_Y);
    const float* DTF = (const float*)(F.wsp() + O_DTF); const float* DTB = (const float*)(F.wsp() + O_DTB);
    const bf16* S = (const bf16*)(F.wsp() + O_H);
    const float Af = -expf(F.inp(17)[l * 8 + h]), Ab = -expf(F.inp(18)[l * 8 + h]);
    const float dsk = F.inp(19)[l * 8 + h];
    const size_t rb = (size_t)c * 128;
    { const float d0 = DTF[(rb + 2 * lane) * 8 + h], d1 = DTF[(rb + 2 * lane + 1) * 8 + h]; const float a0 = d0 * Af, a1 = d1 * Af;
      const float inc = wave_incl_scan(a0 + a1, lane);
      tab[2 * lane] = inc - a1; tab[2 * lane + 1] = inc; tab[256 + 2 * lane] = d0; tab[256 + 2 * lane + 1] = d1; }
    { const float d0 = DTB[(rb + 2 * lane) * 8 + h], d1 = DTB[(rb + 2 * lane + 1) * 8 + h]; const float a0 = d0 * Ab, a1 = d1 * Ab;
      const float inc = wave_incl_scan(a0 + a1, lane); const float tot = __shfl(inc, 63);
      tab[128 + 2 * lane] = tot - (inc - a0 - a1); tab[128 + 2 * lane + 1] = tot - (inc - a1); tab[384 + 2 * lane] = d0; tab[384 + 2 * lane + 1] = d1; }
    asm volatile("s_waitcnt lgkmcnt(0)" ::: "memory");
    const float* cumf = tab; const float* rcum = tab + 128; const float* dtf = tab + 256; const float* dtb = tab + 384;
    const bf16* Hf = S + ((size_t)(0 * NCHUNK + c) * 8 + h) * 8192; const bf16* Hb = S + ((size_t)(1 * NCHUNK + c) * 8 + h) * 8192;
    const float nw0 = F.inp(20)[l * 512 + h * 64 + r32], nw1 = F.inp(20)[l * 512 + h * 64 + 32 + r32];
#pragma unroll 1
    for (int ib = 0; ib < 4; ++ib) {
        bf16x8 cfr[8];
#pragma unroll
        for (int ks = 0; ks < 8; ++ks) cfr[ks] = *(const bf16x8*)(CMp + (rb + 32 * ib + r32) * 256 + g * 128 + 16 * ks + 8 * hi);
        f32x16 ya[2];
#pragma unroll
        for (int pt = 0; pt < 2; ++pt) {
            f32x16 t;
#pragma unroll
            for (int r = 0; r < 16; ++r) t[r] = 0.f;
#pragma unroll
            for (int ks = 0; ks < 8; ++ks) t = MFMA32(cfr[ks], *(const bf16x8*)(Hf + (32 * pt + r32) * 128 + 16 * ks + 8 * hi), t);
#pragma unroll
            for (int r = 0; r < 16; ++r) ya[pt][r] = t[r] * __expf(cumf[32 * ib + crow16(r, hi)]);
            __builtin_amdgcn_sched_barrier(0);
#pragma unroll
            for (int r = 0; r < 16; ++r) t[r] = 0.f;
#pragma unroll
            for (int ks = 0; ks < 8; ++ks) t = MFMA32(cfr[ks], *(const bf16x8*)(Hb + (32 * pt + r32) * 128 + 16 * ks + 8 * hi), t);
#pragma unroll
            for (int r = 0; r < 16; ++r) ya[pt][r] += t[r] * __expf(rcum[32 * ib + crow16(r, hi)]);
            __builtin_amdgcn_sched_barrier(0);
        }
        const float cif = cumf[32 * ib + r32], cib = rcum[32 * ib + r32];
#pragma unroll 1
        for (int jt = 0; jt < 4; ++jt) {
            f32x16 gt;
#pragma unroll
            for (int r = 0; r < 16; ++r) gt[r] = 0.f;
#pragma unroll
            for (int ks = 0; ks < 8; ++ks) gt = MFMA32(*(const bf16x8*)(BMp + (rb + 32 * jt + r32) * 256 + g * 128 + 16 * ks + 8 * hi), cfr[ks], gt);
            __builtin_amdgcn_sched_barrier(0);
#pragma unroll
            for (int r = 0; r < 16; ++r) {
                const int jl = crow16(r, hi), j = 32 * jt + jl;
                float fwd = 0.f, bwd = 0.f;
                if (jt < ib || (jt == ib && jl <= r32)) fwd = __expf(cif - cumf[j]) * dtf[j];
                if (jt > ib || (jt == ib && jl >= r32)) bwd = __expf(cib - rcum[j]) * dtb[j];
                gt[r] = gt[r] * (fwd + bwd);
            }
            __builtin_amdgcn_sched_barrier(0);
#pragma unroll
            for (int s = 0; s < 2; ++s) {
                v4u pa; pa.x = pk2(gt[8 * s], gt[8 * s + 1]); pa.y = pk2(gt[8 * s + 2], gt[8 * s + 3]); pa.z = pk2(gt[8 * s + 4], gt[8 * s + 5]); pa.w = pk2(gt[8 * s + 6], gt[8 * s + 7]);
                const bf16x8 afr = __builtin_bit_cast(bf16x8, pa);
#pragma unroll
                for (int pt = 0; pt < 2; ++pt) { const bf16* xp = XT + (size_t)(h * 64 + 32 * pt + r32) * MALL + rb + 32 * jt + 16 * s + 4 * hi;
                    const v2u lo = *(const v2u*)xp, hi4 = *(const v2u*)(xp + 8); v4u bb; bb.x = lo.x; bb.y = lo.y; bb.z = hi4.x; bb.w = hi4.y;
                    ya[pt] = MFMA32(afr, __builtin_bit_cast(bf16x8, bb), ya[pt]); }
            }
            __builtin_amdgcn_sched_barrier(0);
        }
        float rs[16];
#pragma unroll
        for (int r = 0; r < 16; ++r) rs[r] = 0.f;
#pragma unroll
        for (int pt = 0; pt < 2; ++pt) {
            const int ch = h * 64 + 32 * pt + r32;
#pragma unroll
            for (int q = 0; q < 4; ++q) { const v2u xv = *(const v2u*)(XT + (size_t)ch * MALL + rb + 32 * ib + 8 * q + 4 * hi);
                const float xs[4] = {bflo(xv.x), bfhi(xv.x), bflo(xv.y), bfhi(xv.y)};
#pragma unroll
                for (int e = 0; e < 4; ++e) { const int r = 4 * q + e; const float z = bf1(P2[(rb + 32 * ib + crow16(r, hi)) * P2W + 256 + ch]);
                    const float yv = (ya[pt][r] + dsk * xs[e]) * (z * sigm(z)); ya[pt][r] = yv; rs[r] += yv * yv; } }
            __builtin_amdgcn_sched_barrier(0);
        }
#pragma unroll
        for (int r = 0; r < 16; ++r) { float v = rs[r]; v += __shfl_xor(v, 1); v += __shfl_xor(v, 2); v += __shfl_xor(v, 4); v += __shfl_xor(v, 8); v += __shfl_xor(v, 16); rs[r] = v; }
        float* sq = ssqb + (ib & 1) * 256;
        if (r32 == 0) {
#pragma unroll
            for (int r = 0; r < 16; ++r) sq[h * 32 + crow16(r, hi)] = rs[r];
        }
        __syncthreads();
#pragma unroll
        for (int r = 0; r < 16; ++r) { const int il = crow16(r, hi); float tot = 0.f;
#pragma unroll
            for (int w = 0; w < 8; ++w) tot += sq[w * 32 + il];
            const float rstd = 1.0f / sqrtf(tot * (1.0f / 512.0f) + EPS);
            bf16* yo = Y + (rb + 32 * ib + il) * 1024 + 512 + h * 64 + r32;
            yo[0] = (bf16)f2bf(ya[0][r] * rstd * nw0); yo[32] = (bf16)f2bf(ya[1][r] * rstd * nw1); }
    }
    __syncthreads();
}
template <int NIB> __device__ __forceinline__ void ssd3_unit2(Frame& F, int l, int c, int i0) {
    F.fresh();
    const int lane = F.lane, tid = F.tid, h = F.wave, g = h >> 2, r32 = lane & 31, hi = lane >> 5;
    constexpr int PB = 264;
    bf16* Bs = (bf16*)F.lds; bf16* Cs = Bs + 128 * PB;
    float* tab = (float*)(F.lds + (128 + 64) * PB * 2) + h * 768;
    float* ssqb = (float*)(F.lds + (128 + 64) * PB * 2) + 8 * 768;
    const bf16* XT = (const bf16*)(F.wsp() + O_XT); const bf16* BMp = (const bf16*)(F.wsp() + O_BM); const bf16* CMp = (const bf16*)(F.wsp() + O_CM);
    const bf16* P2 = (const bf16*)(F.wsp() + O_P2); bf16* Y = (bf16*)(F.wsp() + O_Y);
    const float* DTF = (const float*)(F.wsp() + O_DTF); const float* DTB = (const float*)(F.wsp() + O_DTB);
    const bf16* S = (const bf16*)(F.wsp() + O_H);
    const size_t rb = (size_t)c * 128;
    {
        v4u tb[8], tc[2 * NIB];
#pragma unroll
        for (int q = 0; q < 8; ++q) { const int idx = tid + 512 * q; tb[q] = *(const v4u*)(BMp + (rb + (idx >> 5)) * 256 + (idx & 31) * 8); }
#pragma unroll
        for (int q = 0; q < 2 * NIB; ++q) { const int idx = tid + 512 * q; tc[q] = *(const v4u*)(CMp + (rb + i0 + (idx >> 5)) * 256 + (idx & 31) * 8); }
        const float Af = -expf(F.inp(17)[l * 8 + h]), Ab = -expf(F.inp(18)[l * 8 + h]);
        { const float d0 = DTF[(rb + 2 * lane) * 8 + h], d1 = DTF[(rb + 2 * lane + 1) * 8 + h]; const float a0 = d0 * Af, a1 = d1 * Af;
          const float inc = wave_incl_scan(a0 + a1, lane);
          tab[2 * lane] = inc - a1; tab[2 * lane + 1] = inc; tab[256 + 2 * lane] = d0; tab[256 + 2 * lane + 1] = d1;
          const float cend = __shfl(inc, 16 * (lane >> 4) + 15);
          tab[512 + 2 * lane] = __expf(cend - (inc - a1)) * d0; tab[512 + 2 * lane + 1] = __expf(cend - inc) * d1; }
        { const float d0 = DTB[(rb + 2 * lane) * 8 + h], d1 = DTB[(rb + 2 * lane + 1) * 8 + h]; const float a0 = d0 * Ab, a1 = d1 * Ab;
          const float inc = wave_incl_scan(a0 + a1, lane); const float tot = __shfl(inc, 63);
          tab[128 + 2 * lane] = tot - (inc - a0 - a1); tab[128 + 2 * lane + 1] = tot - (inc - a1); tab[384 + 2 * lane] = d0; tab[384 + 2 * lane + 1] = d1;
          const float estart = __shfl(inc - a0 - a1, 16 * (lane >> 4));
          tab[640 + 2 * lane] = __expf((inc - a0 - a1) - estart) * d0; tab[640 + 2 * lane + 1] = __expf((inc - a1) - estart) * d1; }
#pragma unroll
        for (int q = 0; q < 8; ++q) { const int idx = tid + 512 * q; *(v4u*)(Bs + (idx >> 5) * PB + (idx & 31) * 8) = tb[q]; }
#pragma unroll
        for (int q = 0; q < 2 * NIB; ++q) { const int idx = tid + 512 * q; *(v4u*)(Cs + (idx >> 5) * PB + (idx & 31) * 8) = tc[q]; }
    }
    __syncthreads();
    const float* cumf = tab; const float* rcum = tab + 128; const float* dtf = tab + 256; const float* dtb = tab + 384; const float* wjf = tab + 512; const float* wjb = tab + 640;
    const bf16* Hf = S + ((size_t)(0 * NCHUNK + c) * 8 + h) * 8192; const bf16* Hb = S + ((size_t)(1 * NCHUNK + c) * 8 + h) * 8192;
    const bf16* cbase = Cs + r32 * PB + g * 128 + 8 * hi;
    const bf16* bbase = Bs + r32 * PB + g * 128 + 8 * hi;
    const float dsk = F.inp(19)[l * 8 + h];
    f32x16 ya[NIB][2];
#pragma unroll
    for (int a = 0; a < NIB; ++a)
#pragma unroll
        for (int b = 0; b < 2; ++b)
#pragma unroll
            for (int r = 0; r < 16; ++r) ya[a][b][r] = 0.f;
#define SSD3_HLOAD(dst, Hp, pt_) do { _Pragma("unroll") for (int ks = 0; ks < 8; ++ks) dst[ks] = *(const bf16x8*)((Hp) + (size_t)(32 * (pt_) + r32) * 128 + 16 * ks + 8 * hi); } while (0)
#define SSD3_INTER(hq_, pt_, et_) do { _Pragma("unroll") for (int ib2 = 0; ib2 < NIB; ++ib2) { f32x16 t; _Pragma("unroll") for (int r = 0; r < 16; ++r) t[r] = 0.f; \
        _Pragma("unroll") for (int ks = 0; ks < 8; ++ks) t = MFMA32(hq_[ks], *(const bf16x8*)(cbase + 32 * ib2 * PB + 16 * ks), t); \
        const float ei_ = __expf((et_)[i0 + 32 * ib2 + r32]); \
        _Pragma("unroll") for (int r = 0; r < 16; ++r) ya[ib2][pt_][r] += t[r] * ei_; } } while (0)
    {
        bf16x8 hq0[8], hq1[8];
        SSD3_HLOAD(hq0, Hf, 0);
#pragma unroll 1
        for (int dir = 0; dir < 2; ++dir) {
            const bf16* Hc = dir ? Hb : Hf; const float* et = dir ? rcum : cumf;
            SSD3_HLOAD(hq1, Hc, 1);
            SSD3_INTER(hq0, 0, et);
            SSD3_HLOAD(hq0, Hb, 0);
            SSD3_INTER(hq1, 1, et);
        }
    }
#define SSD3_ZLOAD(dst, ib2_) do { _Pragma("unroll") for (int pt = 0; pt < 2; ++pt) _Pragma("unroll") for (int q = 0; q < 4; ++q) dst[pt][q] = __builtin_nontemporal_load((const v2u*)(P2 + (rb + i0 + 32 * (ib2_) + r32) * P2W + 256 + h * 64 + 32 * pt + 8 * q + 4 * hi)); } while (0)
    v2u zv0[2][4], zv1[2][4];
#define SSD3_XLOAD(dst, jt_) do { _Pragma("unroll") for (int s2 = 0; s2 < 2; ++s2) _Pragma("unroll") for (int pt = 0; pt < 2; ++pt) { \
        const bf16* xp = XT + (size_t)(h * 64 + 32 * pt + r32) * MALL + rb + 32 * (jt_) + 16 * s2 + 4 * hi; dst[s2][pt][0] = *(const v2u*)xp; dst[s2][pt][1] = *(const v2u*)(xp + 8); } } while (0)
#define SSD3_INTRA(xq_, jt_) do { _Pragma("unroll") for (int ib2 = 0; ib2 < NIB; ++ib2) { const int ib = (i0 >> 5) + ib2; f32x16 gt; _Pragma("unroll") for (int r = 0; r < 16; ++r) gt[r] = 0.f; \
        _Pragma("unroll") for (int ks = 0; ks < 8; ++ks) gt = MFMA32(*(const bf16x8*)(bbase + 32 * (jt_) * PB + 16 * ks), *(const bf16x8*)(cbase + 32 * ib2 * PB + 16 * ks), gt); \
        const float cif = cumf[32 * ib + r32], cib = rcum[32 * ib + r32]; \
        if ((jt_) < ib) { const float rf = __expf(cif - cumf[32 * (jt_) + 31]); _Pragma("unroll") for (int r = 0; r < 16; ++r) gt[r] *= rf * wjf[32 * (jt_) + crow16(r, hi)]; } \
        else if ((jt_) > ib) { const float rf = __expf(cib - rcum[32 * (jt_)]); _Pragma("unroll") for (int r = 0; r < 16; ++r) gt[r] *= rf * wjb[32 * (jt_) + crow16(r, hi)]; } \
        else { _Pragma("unroll") for (int r = 0; r < 16; ++r) { const int jl = crow16(r, hi), j = 32 * (jt_) + jl; \
            const float fwd = jl <= r32 ? __expf(cif - cumf[j]) * dtf[j] : 0.f, bwd = jl >= r32 ? __expf(cib - rcum[j]) * dtb[j] : 0.f; gt[r] = gt[r] * (fwd + bwd) + (jl == r32 ? dsk : 0.f); } } \
        _Pragma("unroll") for (int s2 = 0; s2 < 2; ++s2) { \
            v4u pa; pa.x = pk2(gt[8 * s2], gt[8 * s2 + 1]); pa.y = pk2(gt[8 * s2 + 2], gt[8 * s2 + 3]); pa.z = pk2(gt[8 * s2 + 4], gt[8 * s2 + 5]); pa.w = pk2(gt[8 * s2 + 6], gt[8 * s2 + 7]); \
            const bf16x8 afr = __builtin_bit_cast(bf16x8, pa); \
            _Pragma("unroll") for (int pt = 0; pt < 2; ++pt) { v4u bb; bb.x = xq_[s2][pt][0].x; bb.y = xq_[s2][pt][0].y; bb.z = xq_[s2][pt][1].x; bb.w = xq_[s2][pt][1].y; \
                ya[ib2][pt] = MFMA32(__builtin_bit_cast(bf16x8, bb), afr, ya[ib2][pt]); } } \
        __builtin_amdgcn_sched_barrier(0); } } while (0)
    {
        v2u xq0[2][2][2], xq1[2][2][2];
        SSD3_XLOAD(xq0, 0);
#pragma unroll 1
        for (int jp = 0; jp < 2; ++jp) {
            SSD3_XLOAD(xq1, 2 * jp + 1);
            SSD3_INTRA(xq0, 2 * jp);
            SSD3_XLOAD(xq0, (2 * jp + 2) & 3);
            SSD3_INTRA(xq1, 2 * jp + 1);
        }
    }
#undef SSD3_HLOAD
#undef SSD3_INTER
#undef SSD3_XLOAD
#undef SSD3_INTRA
#define SSD3_EPI(ib2, zv_) do { float rsum = 0.f; \
        _Pragma("unroll") for (int pt = 0; pt < 2; ++pt) _Pragma("unroll") for (int q = 0; q < 4; ++q) { const v2u zz = zv_[pt][q]; const float zf[4] = {bflo(zz.x), bfhi(zz.x), bflo(zz.y), bfhi(zz.y)}; \
            _Pragma("unroll") for (int e = 0; e < 4; ++e) { const int r = 4 * q + e; const float yv = ya[ib2][pt][r] * (zf[e] * sigm(zf[e])); ya[ib2][pt][r] = yv; rsum += yv * yv; } } \
        rsum += __shfl_xor(rsum, 32); \
        float* sq = ssqb + (ib2) * 256; \
        if (hi == 0) sq[h * 32 + r32] = rsum; \
        __syncthreads(); \
        float tot = 0.f; _Pragma("unroll") for (int w = 0; w < 8; ++w) tot += sq[w * 32 + r32]; \
        const float rstd = 1.0f / sqrtf(tot * (1.0f / 512.0f) + EPS); \
        bf16* yo = Y + (rb + i0 + 32 * (ib2) + r32) * 1024 + 512 + h * 64 + 4 * hi; const float* nwp = F.inp(20) + l * 512 + h * 64 + 4 * hi; \
        _Pragma("unroll") for (int pt = 0; pt < 2; ++pt) _Pragma("unroll") for (int q = 0; q < 4; ++q) { const f32x4 nw = *(const f32x4*)(nwp + 32 * pt + 8 * q); \
            v2u o; o.x = pk2(ya[ib2][pt][4 * q] * rstd * nw.x, ya[ib2][pt][4 * q + 1] * rstd * nw.y); o.y = pk2(ya[ib2][pt][4 * q + 2] * rstd * nw.z, ya[ib2][pt][4 * q + 3] * rstd * nw.w); \
            *(v2u*)(yo + 32 * pt + 8 * q) = o; } \
        __builtin_amdgcn_sched_barrier(0); } while (0)
    SSD3_ZLOAD(zv0, 0);
    SSD3_EPI(0, zv0);
    if constexpr (NIB == 2) { SSD3_ZLOAD(zv1, 1); SSD3_EPI(1, zv1); }
#undef SSD3_EPI
#undef SSD3_ZLOAD
    __syncthreads();
}
__device__ __forceinline__ void phase_mix(Frame& F, int l) {
    using abf = attn_body::bf16;
    const abf* Yq = (const abf*)(F.wsp() + O_Y); const abf* KN = (const abf*)(F.wsp() + O_KN); const abf* VN = (const abf*)(F.wsp() + O_VN);
    for (int rp_ = 0; rp_ < ((REPM & 64) ? 2 : 1); ++rp_) {
        for (int u = F.bid; u < 256; u += F.G) ssd3_unit2<2>(F, l, u >> 1, (u & 1) * 64);
        if (l == 0) for (int q = (F.bid + F.G - 64 % F.G) % F.G; q < 64; q += F.G) ssd3_unit2<1>(F, l, 128 + (q >> 2), (q & 3) * 32);
    }
    __syncthreads();
    if (REPM & 1024) for (int u = F.bid; u < 512; u += F.G) {
        const int b = u >> 6, hq = (u >> 3) & 7, qb = u & 7; const size_t qrow = (size_t)b * SEQ + qb * 256;
        attn_body::attn_unit<8, P2W>(Yq + qrow * 1024 + hq * 64, KN + (size_t)b * KVLEN * 128 + (hq >> 2) * 64, VN + (size_t)b * KVLEN * 128 + (hq >> 2) * 64, (abf*)(F.wsp() + O_P2) + qrow * P2W + 768 + hq * 64, KVLEN / 64, (char*)F.lds);
    }
    const int vcu = (F.G % 8 == 0) ? (F.bid & 7) * (F.G >> 3) + (F.bid >> 3) : F.bid;
    for (int u = vcu; u < 512; u += F.G) {
        const int b = u >> 6, hq = (u >> 3) & 7, qb = u & 7; const size_t qrow = (size_t)b * SEQ + qb * 256;
        attn_body::attn_unit<8>(Yq + qrow * 1024 + hq * 64, KN + (size_t)b * KVLEN * 128 + (hq >> 2) * 64, VN + (size_t)b * KVLEN * 128 + (hq >> 2) * 64, (abf*)Yq + qrow * 1024 + hq * 64, KVLEN / 64, (char*)F.lds);
    }
    if (l == 0) {
        for (int u = F.bid; u < 64; u += F.G) {
            const int b = u >> 3, hq = u & 7; const size_t qrow = (size_t)NLAT + b * CTXL;
            attn_body::attn_unit<8>(Yq + qrow * 1024 + hq * 64, KN + (size_t)b * KVLEN * 128 + (hq >> 2) * 64, VN + (size_t)b * KVLEN * 128 + (hq >> 2) * 64, (abf*)Yq + qrow * 1024 + hq * 64, CTXL / 64, (char*)F.lds);
        }
    }
}
template <int GC> __global__ void __launch_bounds__(NWAVES * 64, 2) hybrid_fwd(Args args) {
    extern __shared__ __attribute__((aligned(16))) unsigned char lds[];
    cg::grid_group grid = cg::this_grid();
    volatile LAS unsigned* bst = (volatile LAS unsigned*)((LAS unsigned char*)lds + RING_BYTES + 320);
    if (threadIdx.x < 2) bst[threadIdx.x] = 0u;
    __syncthreads();
    (void)xcd_barrier_post((unsigned*)args.ws, bst);
    Frame F;
    F.lds = lds; F.tid = threadIdx.x; F.lane = F.tid & 63; F.wave = __builtin_amdgcn_readfirstlane(F.tid >> 6); F.G = GC ? GC : (int)gridDim.x; F.bid = blockIdx.x;
    F.ap = (kargp_t)__builtin_amdgcn_kernarg_segment_ptr();
    F.out = args.out; F.ws = args.ws;
    PG8_LAS unsigned char* ldsg = (PG8_LAS unsigned char*)lds;
    pg8::bf16_t* Hb = (pg8::bf16_t*)(F.wsp() + O_H);

#define GSYNC() do { XcdBarrier b_; b_.bar = (unsigned*)F.wsp(); b_.x = xb_xcc_id(); b_.st = bst; xcd_barrier(b_); if (REPM & 1) xcd_barrier(b_); } while (0)
    for (int rp_ = 0; rp_ < ((REPM & 128) ? 2 : 1); ++rp_) if (PHM & 1) phase_prologue(F);
    if (args.ws == nullptr) grid.sync();
    GSYNC();
    for (int rp_ = 0; rp_ < ((REPM & 512) ? 2 : 1); ++rp_) if (PHM & 2) phase_rows<false, true, true>(F, 0, MALL, 0, F.G, true, 0, 0, 0, 0, 0, 6);
    GSYNC();
#ifndef LUNROLL
#define LUNROLL 2
#endif
#pragma unroll LUNROLL
    for (int l = 0; l < DEPTH; ++l) {
        const pg8::bf16_t* wl = (const pg8::bf16_t*)(F.wsp() + O_W + (size_t)l * WL_SIZE);
        const int mrows = l == 0 ? MALL : NLAT;
        for (int rp_ = 0; rp_ < ((REPM & 2) ? 2 : 1); ++rp_) if (PHM & 4) {
            pg8::Gemm g{Hb, wl + WL_IN / 2, MALL, NIN, 1024}; pg8::StaticOrder S; S.init(MALL, NIN, F.G, F.bid);
            pg8::EpiStoreBf16 E{(pg8::bf16_t*)(F.wsp() + O_Y), 1024, (pg8::bf16_t*)(F.wsp() + O_P2), P2W, 2};
            pg8::gemm_phase<pg8::EpiStoreBf16, pg8::StaticOrder, PG8_ALIGN, PG8_SP2>(ldsg, g, S, E);
        }
        GSYNC();
        if (PHM & 8) phase_post(F, l);
        GSYNC();
#ifndef SSD12
#define SSD12 0
#endif
        if (SSD12) { for (int rp_ = 0; rp_ < ((REPM & 32) ? 2 : 1); ++rp_) phase_ssd12(F, l); }
        else { phase_ssd1(F, l); GSYNC(); phase_ssd2(F); }
        GSYNC();
        if (PHM & 64) phase_mix(F, l);
        GSYNC();
        const int nparts = l == 0 ? 2 : 1;
        for (int part = 0; part < nparts; ++part) {
            const bool cx = part == 1; const size_t roff = cx ? (size_t)NLAT * 1024 : 0;
            if (!cx || F.bid < 32) {
                pg8::Gemm g{(const pg8::bf16_t*)(F.wsp() + O_Y) + roff, wl + WL_OUT / 2, cx ? NCTX : NLAT, 1024, 1024}; pg8::StaticOrder S; S.init(cx ? NCTX : NLAT, 1024, cx ? 32 : F.G, F.bid);
                pg8::EpiStoreBf16 E{Hb + roff, 1024, Hb + roff, 1024, 1 << 20};
                pg8::gemm_phase<pg8::EpiStoreBf16, pg8::StaticOrder, PG8_ALIGN, PG8_SP2>(ldsg, g, S, E);
            }
            if (cx) phase_rows<true, true, false>(F, 0, NLAT, 32, F.G - 32, true, l, 2, 7, l, 3, 8);
            GSYNC();
        }
        phase_rows<true, true, false>(F, l == 0 ? NLAT : 0, l == 0 ? MALL : NLAT, 0, F.G, l == 0, l, 2, 7, l, 3, 8);
        GSYNC();
        for (int rp_ = 0; rp_ < ((REPM & 8) ? 2 : 1); ++rp_) if (PHM & 512) {
            pg8::Gemm g{Hb, wl + WL_GU / 2, mrows, 2 * DFF, 1024}; pg8::StaticOrder S; S.init(mrows, 2 * DFF, F.G, F.bid);
            pg8::EpiSwiGLU E{(pg8::bf16_t*)(F.wsp() + O_ACT), DFF};
            pg8::gemm_phase<pg8::EpiSwiGLU, pg8::StaticOrder, PG8_ALIGN, PG8_SP2>(ldsg, g, S, E);
        }
        GSYNC();
        for (int part = 0; part < nparts; ++part) {
            const bool cx = part == 1; const size_t roff = cx ? (size_t)NLAT : 0;
            if (l + 1 == DEPTH && F.G == 256) {
                pg8::Gemm g{(const pg8::bf16_t*)(F.wsp() + O_ACT), wl + WL_D / 2, NLAT, 1024, DFF}; pg8::StaticOrder S; S.init(NLAT, 1024, F.G, F.bid);
                pg8::Unit u0; S.next(0, u0);
                pg8::EpiRmsRes E{F.outp(), F.outp(), 1024, (const float*)(F.wsp() + O_MOD) + ((size_t)l * 9 + (u0.pm >> 3)) * 6144 + 5 * 1024, F.inp(9) + (size_t)l * 1024,
                                 (float*)(F.wsp() + O_XS), (unsigned*)(F.wsp() + CTL_PANEL), EPS};
                pg8::gemm_phase<pg8::EpiRmsRes, pg8::StaticOrder, false, PG8_SP2>(ldsg, g, S, E);
            } else
            if (!cx || F.bid < 32) {
                pg8::Gemm g{(const pg8::bf16_t*)(F.wsp() + O_ACT) + roff * DFF, wl + WL_D / 2, cx ? NCTX : NLAT, 1024, DFF}; pg8::StaticOrder S; S.init(cx ? NCTX : NLAT, 1024, cx ? 32 : F.G, F.bid);
                pg8::EpiStoreBf16 E{Hb + roff * 1024, 1024, Hb + roff * 1024, 1024, 1 << 20};
                pg8::gemm_phase<pg8::EpiStoreBf16, pg8::StaticOrder, PG8_ALIGN, PG8_SP2>(ldsg, g, S, E);
            }
            if (cx) phase_rows<true, true, true>(F, 0, NLAT, 32, F.G - 32, false, l, 5, 9, l + 1, 0, 6);
            if (!(l + 1 == DEPTH && F.G == 256)) GSYNC();
        }
        if (l + 1 < DEPTH) { phase_rows<true, true, true>(F, NLAT, MALL, 0, F.G, false, l, 5, 9, l + 1, 0, 6); GSYNC(); }
        else if (F.G != 256) phase_rows<true, false, false>(F, 0, NLAT, 0, F.G, false, l, 5, 9, 0, 0, 0);
    }
}
extern "C" void kernel_launch(void* const* d_in, const int* in_sizes, int n_in, void* d_out, int out_size, void* d_ws, size_t ws_size, hipStream_t stream) {
    static int grid = 0; static const void* kfn = (const void*)hybrid_fwd<0>;
    if (grid == 0) {
        if (n_in != 25 || in_sizes[0] != NLAT * 1024 || out_size != NLAT * 1024 || ws_size < O_END2) { fprintf(stderr, "kernel_launch: unexpected problem (n_in %d, ws %zu, need %zu)\n", n_in, ws_size, (size_t)O_END2); grid = -1; return; }
        int dev = 0, cus = 0, per_cu = 0;
        hipGetDevice(&dev); hipDeviceGetAttribute(&cus, hipDeviceAttributeMultiprocessorCount, dev);
        if (hipFuncSetAttribute(kfn, hipFuncAttributeMaxDynamicSharedMemorySize, LDS_BYTES) != hipSuccess) { fprintf(stderr, "kernel_launch: hipFuncSetAttribute failed\n"); grid = -1; return; }
        if (hipOccupancyMaxActiveBlocksPerMultiprocessor(&per_cu, kfn, NWAVES * 64, LDS_BYTES) != hipSuccess || per_cu < 1) { fprintf(stderr, "kernel_launch: occupancy query gave %d\n", per_cu); per_cu = 1; }
        (void)hipGetLastError();
        grid = cus * per_cu;
        if (grid == 256) { kfn = (const void*)hybrid_fwd<256>;
            if (hipFuncSetAttribute(kfn, hipFuncAttributeMaxDynamicSharedMemorySize, LDS_BYTES) != hipSuccess) { fprintf(stderr, "kernel_launch: hipFuncSetAttribute failed\n"); grid = -1; return; } }
        fprintf(stderr, "kernel_launch: grid %d (cus %d x %d)\n", grid, cus, per_cu);
    }
    if (grid < 0) return;
    if (hipMemsetAsync(d_ws, 0, CTL_BYTES, stream) != hipSuccess) { fprintf(stderr, "kernel_launch: memset failed\n"); return; }
    Args a{};
    for (int i = 0; i < 25; ++i) a.in[i] = (const float*)d_in[i];
    a.out = (float*)d_out; a.ws = (unsigned char*)d_ws;
    void* kargs[] = {&a};
    const hipError_t e = hipLaunchCooperativeKernel(kfn, dim3(grid), dim3(NWAVES * 64), kargs, LDS_BYTES, stream);
    if (e != hipSuccess) fprintf(stderr, "kernel_launch: cooperative launch failed: %s (grid %d)\n", hipGetErrorString(e), grid);
}
```

```cpp
#include <hip/hip_runtime.h>
#include <hip/hip_cooperative_groups.h>
#include <hip/hip_bf16.h>
#include <cstdio>
#include <cstdint>
#include <cmath>
namespace cg = cooperative_groups;
#ifndef PHM
#define PHM 0xffff
#endif
#ifndef REPM
#define REPM 0
#endif
namespace pg8 {
#define PG8_LAS __attribute__((address_space(3)))
typedef unsigned short bf16_t;
typedef short bf16x8 __attribute__((ext_vector_type(8)));
typedef float f32x4 __attribute__((ext_vector_type(4)));
typedef unsigned u32x4 __attribute__((ext_vector_type(4)));
constexpr int BM = 256, BK = 64, HALF = 128, HTB = HALF * BK * 2  , STAGE_BYTES = 8 * HTB, NXCD = 8, WGM = 8;

__host__ __device__ __forceinline__ int lds_byte(int r, int c) { const int st = (r >> 4) * 2 + (c >> 5), rr = r & 15, cc = c & 31, ob = rr * 64 + cc * 2; return st * 1024 + (ob ^ (((ob >> 9) & 1) << 5)); }
__host__ __device__ __forceinline__ void stage_rc(int b, int& R, int& C) { const int st = b / 1024, sb = b % 1024, swz = sb ^ (((sb >> 9) & 1) << 5); R = (st >> 1) * 16 + swz / 64; C = (st & 1) * 32 + (swz % 64) / 2; }
__host__ __device__ __forceinline__ int perm32(int rho) { const int n = rho >> 4, i = rho & 15; return 8 * (i >> 2) + 4 * n + (i & 3); }

struct Unit { int pm, pn; };
struct Gemm { const bf16_t* A; const bf16_t* Bt; int M, N, K; };

struct StaticOrder {
    int nM, nN, nwg, G, c;
    __host__ __device__ void init(int M, int N, int G_, int c_) { nM = M / BM; nN = N / BM; nwg = nM * nN; G = G_; c = c_; }
    __host__ __device__ __forceinline__ bool next(int i, Unit& u) const {
        const long L = (long)i * G + c; if (L >= nwg) return false;
        int wgid = (int)L; { const int q = nwg / NXCD, r = nwg % NXCD, xcd = wgid % NXCD, off = wgid / NXCD; wgid = (xcd < r ? xcd * (q + 1) : r * (q + 1) + (xcd - r) * q) + off; }
        const int nig = WGM * nN, gid = wgid / nig, fm = gid * WGM, gsz = (nM - fm) < WGM ? (nM - fm) : WGM;
        u.pm = fm + ((wgid % nig) % gsz); u.pn = (wgid % nig) / gsz; return true;
    }
    __device__ __forceinline__ void a_ready(const Unit&) const {}
    __device__ __forceinline__ void done(const Unit&) const {}
};

__device__ __forceinline__ unsigned cvt_pk_bf16(float lo, float hi) { unsigned r; asm volatile("v_cvt_pk_bf16_f32 %0, %1, %2" : "=v"(r) : "v"(lo), "v"(hi)); return r; }
typedef float f32x2 __attribute__((ext_vector_type(2)));
typedef float f32x2 __attribute__((ext_vector_type(2)));
template <class Epi, class Sched, bool ALIGN_EPI = false, bool SP2 = false>
__device__ __forceinline__ void gemm_phase(PG8_LAS unsigned char* lds, const Gemm g, const Sched& S, const Epi& E) {
    int tid_ = threadIdx.x; asm volatile("" : "+v"(tid_));
    const int tid = tid_, wid = __builtin_amdgcn_readfirstlane(tid >> 6), lane = tid & 63, wr = wid >> 2, wc = wid & 3, fr = lane & 15, fq = lane >> 4;
    const int K = g.K, nt = K / BK;
    unsigned voffA[2], voffB[2];
#pragma unroll
    for (int i = 0; i < 2; ++i) { int R, C; stage_rc(tid * 16 + i * 8192, R, C); const int Rb = Epi::PERM ? ((R & ~31) + perm32(R & 31)) : R;
        voffA[i] = (unsigned)(R * K + C) * 2u; voffB[i] = (unsigned)(Rb * K + C) * 2u; }
    const size_t kstep = (size_t)(BK * 2);
    const size_t hstep = (size_t)HALF * K * 2;
    const size_t tstep = 2 * hstep;
    const unsigned ldsw = (unsigned)wid * 1024u;
    const int aoff = lds_byte(wr * 64 + fr, fq * 8), boff = lds_byte(wc * 32 + fr, fq * 8);
#define PG8_SA(b, h) (((b) * 2 + (h)) * HTB)
#define PG8_SB(b, h) ((4 + (b) * 2 + (h)) * HTB)
#define PG8_STAGE(bufoff, gbase, voff) do { _Pragma("unroll") for (int _i = 0; _i < 2; ++_i) \
        __builtin_amdgcn_global_load_lds((const unsigned*)((const char*)(gbase) + (voff)[_i]), (PG8_LAS unsigned*)(lds + (bufoff) + ldsw + _i * 8192), 16, 0, 0); } while (0)
#define PG8_LDA(dst, b, h) do { _Pragma("unroll") for (int m = 0; m < 4; ++m) _Pragma("unroll") for (int k = 0; k < 2; ++k) dst[m][k] = *(const PG8_LAS bf16x8*)(lds + PG8_SA(b, h) + aoff + m * 2048 + k * 1024); } while (0)
#define PG8_LDB(dst, b, h) do { _Pragma("unroll") for (int n = 0; n < 2; ++n) _Pragma("unroll") for (int k = 0; k < 2; ++k) dst[n][k] = *(const PG8_LAS bf16x8*)(lds + PG8_SB(b, h) + boff + n * 2048 + k * 1024); } while (0)
#define PG8_MMA(ai, bj, At, Bt) do { __builtin_amdgcn_s_setprio(1); _Pragma("unroll") for (int m = 0; m < 4; ++m) _Pragma("unroll") for (int n = 0; n < 2; ++n) _Pragma("unroll") for (int k = 0; k < 2; ++k) \
        acc[ai][bj][m][n] = __builtin_amdgcn_mfma_f32_16x16x32_bf16(Bt[n][k], At[m][k], acc[ai][bj][m][n], 0, 0, 0); __builtin_amdgcn_s_setprio(0); } while (0)
#define PG8_WAIT_V(n) asm volatile("s_waitcnt vmcnt(" #n ")" ::: "memory")
#define PG8_WAIT_L(n) asm volatile("s_waitcnt lgkmcnt(" #n ")" ::: "memory")
#define PG8_BAR __builtin_amdgcn_s_barrier()
#define PG8_SCHED __builtin_amdgcn_sched_barrier(0)
    Unit cur, nxt; int ui = 0;
    if (!S.next(0, cur)) return;
    f32x4 acc[2][2][4][2];
#pragma unroll
    for (int a = 0; a < 2; ++a)
#pragma unroll
        for (int b = 0; b < 2; ++b)
#pragma unroll
            for (int m = 0; m < 4; ++m)
#pragma unroll
                for (int n = 0; n < 2; ++n) acc[a][b][m][n] = (f32x4){0.f, 0.f, 0.f, 0.f};
    bf16x8 At[4][2], B0[2][2], B1[2][2];
    const char* cA = (const char*)g.A + (size_t)cur.pm * tstep; const char* cB = (const char*)g.Bt + (size_t)cur.pn * tstep;
    S.a_ready(cur);
    if constexpr (SP2) {
        PG8_STAGE(PG8_SB(0, 0), cB, voffB); PG8_STAGE(PG8_SB(0, 1), cB + hstep, voffB); PG8_STAGE(PG8_SA(0, 0), cA, voffA); PG8_STAGE(PG8_SA(0, 1), cA + hstep, voffA);
        if (wr == 1) PG8_BAR;
        PG8_WAIT_V(2); PG8_BAR;
        PG8_STAGE(PG8_SB(1, 0), cB + kstep, voffB); PG8_STAGE(PG8_SA(1, 0), cA + kstep, voffA); PG8_STAGE(PG8_SB(1, 1), cB + hstep + kstep, voffB);
        PG8_WAIT_V(6); PG8_BAR;
    } else {
        PG8_STAGE(PG8_SB(0, 0), cB, voffB); PG8_STAGE(PG8_SA(0, 0), cA, voffA); PG8_STAGE(PG8_SB(0, 1), cB + hstep, voffB); PG8_STAGE(PG8_SA(0, 1), cA + hstep, voffA);
        if (wr == 1) PG8_BAR;
        PG8_WAIT_V(4); PG8_BAR;
        PG8_STAGE(PG8_SB(1, 0), cB + kstep, voffB); PG8_STAGE(PG8_SA(1, 0), cA + kstep, voffA); PG8_STAGE(PG8_SB(1, 1), cB + hstep + kstep, voffB);
        PG8_WAIT_V(6); PG8_BAR;
    }
    for (;;) {
        const bool has_next = S.next(ui + 1, nxt);
        const char* nA = has_next ? (const char*)g.A + (size_t)nxt.pm * tstep : cA; const char* nB = has_next ? (const char*)g.Bt + (size_t)nxt.pn * tstep : cB;
        for (int t = 0; t < nt; t += 2) {
            const bool last = (t == nt - 2);
            const char* a1 = cA + (size_t)(t + 1) * kstep;
            const char* a2 = last ? nA : cA + (size_t)(t + 2) * kstep; const char* b2 = last ? nB : cB + (size_t)(t + 2) * kstep;
            const char* a3 = a2 + kstep; const char* b3 = b2 + kstep;
            if (last && has_next) S.a_ready(nxt);
            if constexpr (SP2) {
            PG8_LDB(B0, 0, 0); PG8_LDB(B1, 0, 1); PG8_SCHED; PG8_LDA(At, 0, 0); PG8_STAGE(PG8_SA(1, 1), a1 + hstep, voffA);
            PG8_WAIT_V(8); PG8_WAIT_L(0); PG8_BAR; PG8_MMA(0, 0, At, B0); PG8_MMA(0, 1, At, B1); PG8_BAR; PG8_SCHED;
            PG8_LDA(At, 0, 1); PG8_STAGE(PG8_SB(0, 0), b2, voffB); PG8_STAGE(PG8_SB(0, 1), b2 + hstep, voffB); PG8_STAGE(PG8_SA(0, 0), a2, voffA);
            PG8_WAIT_V(8); PG8_WAIT_L(0); PG8_BAR; PG8_MMA(1, 0, At, B0); PG8_MMA(1, 1, At, B1); PG8_BAR; PG8_SCHED;
            PG8_LDB(B0, 1, 0); PG8_LDB(B1, 1, 1); PG8_SCHED; PG8_LDA(At, 1, 0); PG8_STAGE(PG8_SA(0, 1), a2 + hstep, voffA);
            PG8_WAIT_V(8); PG8_WAIT_L(0); PG8_BAR; PG8_MMA(0, 0, At, B0); PG8_MMA(0, 1, At, B1); PG8_BAR; PG8_SCHED;
            PG8_LDA(At, 1, 1); PG8_STAGE(PG8_SB(1, 0), b3, voffB); PG8_STAGE(PG8_SB(1, 1), b3 + hstep, voffB); PG8_STAGE(PG8_SA(1, 0), a3, voffA);
            PG8_WAIT_V(8); PG8_WAIT_L(0); PG8_BAR; PG8_MMA(1, 0, At, B0); PG8_MMA(1, 1, At, B1); PG8_BAR; PG8_SCHED;
            } else {
            PG8_LDB(B0, 0, 0); PG8_SCHED; PG8_LDA(At, 0, 0); PG8_STAGE(PG8_SA(1, 1), a1 + hstep, voffA);
            PG8_WAIT_L(8); PG8_BAR; PG8_WAIT_L(0); PG8_MMA(0, 0, At, B0); PG8_BAR; PG8_SCHED;
            PG8_LDB(B1, 0, 1); PG8_STAGE(PG8_SB(0, 0), b2, voffB);
            PG8_BAR; PG8_WAIT_L(0); PG8_MMA(0, 1, At, B1); PG8_BAR;
            PG8_LDA(At, 0, 1); PG8_STAGE(PG8_SA(0, 0), a2, voffA);
            PG8_BAR; PG8_WAIT_L(0); PG8_MMA(1, 0, At, B0); PG8_BAR; PG8_SCHED;
            PG8_STAGE(PG8_SB(0, 1), b2 + hstep, voffB);
            PG8_WAIT_V(6); PG8_BAR; PG8_MMA(1, 1, At, B1); PG8_BAR;
            PG8_LDB(B0, 1, 0); PG8_SCHED; PG8_LDA(At, 1, 0); PG8_STAGE(PG8_SA(0, 1), a2 + hstep, voffA);
            PG8_WAIT_L(8); PG8_BAR; PG8_WAIT_L(0); PG8_MMA(0, 0, At, B0); PG8_BAR; PG8_SCHED;
            PG8_LDB(B1, 1, 1); PG8_STAGE(PG8_SB(1, 0), b3, voffB);
            PG8_BAR; PG8_WAIT_L(0); PG8_MMA(0, 1, At, B1); PG8_BAR;
            PG8_LDA(At, 1, 1); PG8_STAGE(PG8_SA(1, 0), a3, voffA);
            PG8_BAR; PG8_WAIT_L(0); PG8_MMA(1, 0, At, B0); PG8_BAR; PG8_SCHED;
            PG8_STAGE(PG8_SB(1, 1), b3 + hstep, voffB);
            PG8_WAIT_V(6); PG8_BAR; PG8_MMA(1, 1, At, B1); PG8_BAR;
            }
        }
        if constexpr (ALIGN_EPI) { if (wr == 0) PG8_BAR; }
        if constexpr (!Epi::AFTER_DRAIN) { E(acc, cur, wr, wc, fr, fq); S.done(cur); }
        if (!has_next) break;
#pragma unroll
        for (int a = 0; a < 2; ++a)
#pragma unroll
            for (int b = 0; b < 2; ++b)
#pragma unroll
                for (int m = 0; m < 4; ++m)
#pragma unroll
                    for (int n = 0; n < 2; ++n) acc[a][b][m][n] = (f32x4){0.f, 0.f, 0.f, 0.f};
        cur = nxt; cA = nA; cB = nB; ++ui;
        if constexpr (ALIGN_EPI) { if (wr == 1) PG8_BAR; }
    }
    PG8_WAIT_V(0);
    if constexpr (!ALIGN_EPI) { if (wr == 0) PG8_BAR; }
    PG8_BAR;
    if constexpr (Epi::AFTER_DRAIN) { E.fused(acc, cur, wr, wc, fr, fq, lds, wid, lane); S.done(cur); }
#undef PG8_SA
#undef PG8_SB
#undef PG8_STAGE
#undef PG8_LDA
#undef PG8_LDB
#undef PG8_MMA
#undef PG8_WAIT_V
#undef PG8_WAIT_L
#undef PG8_BAR
#undef PG8_SCHED
}
}
namespace pg8 {
struct EpiStoreBf16 {
    static constexpr bool PERM = true, AFTER_DRAIN = false;
    bf16_t* O0; int ld0; bf16_t* O1; int ld1; int split_pn;
    __device__ __forceinline__ void operator()(const f32x4 (&acc)[2][2][4][2], const Unit& u, int wr, int wc, int fr, int fq) const {
        const int row0 = u.pm * BM + wr * 64 + fr;
        bf16_t* base; int ld, colt;
        if (u.pn < split_pn) { base = O0; ld = ld0; colt = u.pn * BM; } else { base = O1; ld = ld1; colt = (u.pn - split_pn) * BM; }
        const int col0 = colt + wc * 32 + 8 * fq;
#pragma unroll
        for (int ai = 0; ai < 2; ++ai)
#pragma unroll
            for (int m = 0; m < 4; ++m) { bf16_t* rowp = base + (size_t)(row0 + ai * HALF + m * 16) * ld + col0;
#pragma unroll
                for (int bj = 0; bj < 2; ++bj) { const f32x4 v0 = acc[ai][bj][m][0], v1 = acc[ai][bj][m][1];
                    u32x4 w; w.x = cvt_pk_bf16(v0[0], v0[1]); w.y = cvt_pk_bf16(v0[2], v0[3]); w.z = cvt_pk_bf16(v1[0], v1[1]); w.w = cvt_pk_bf16(v1[2], v1[3]);
                    *(u32x4*)(rowp + bj * HALF) = w; } }
    }
};
struct EpiSwiGLU {
    static constexpr bool PERM = true, AFTER_DRAIN = false;
    bf16_t* O; int ldc;
    __device__ __forceinline__ void operator()(const f32x4 (&acc)[2][2][4][2], const Unit& u, int wr, int wc, int fr, int fq) const {
        const int row0 = u.pm * BM + wr * 64 + fr;
        const int col0 = u.pn * 128 + wc * 32 + 8 * fq;
#pragma unroll
        for (int ai = 0; ai < 2; ++ai)
#pragma unroll
            for (int m = 0; m < 4; ++m) { bf16_t* rowp = O + (size_t)(row0 + ai * HALF + m * 16) * ldc + col0; f32x4 o[2];
#pragma unroll
                for (int n = 0; n < 2; ++n) { const f32x4 g = acc[ai][0][m][n], up = acc[ai][1][m][n];
#pragma unroll
                    for (int e = 0; e < 4; ++e) o[n][e] = g[e] * up[e] * __builtin_amdgcn_rcpf(1.0f + __expf(-g[e])); }
                u32x4 w; w.x = cvt_pk_bf16(o[0][0], o[0][1]); w.y = cvt_pk_bf16(o[0][2], o[0][3]); w.z = cvt_pk_bf16(o[1][0], o[1][1]); w.w = cvt_pk_bf16(o[1][2], o[1][3]);
                *(u32x4*)rowp = w; }
    }
};
struct EpiRmsRes {
    static constexpr bool PERM = false, AFTER_DRAIN = true;
    const float* base; float* out; int ldc; const float* gate; const float* w; float* slots; unsigned* cnt; float eps;
    __device__ __forceinline__ void fused(f32x4 (&acc)[2][2][4][2], const Unit& u, int wr, int wc, int fr, int fq, PG8_LAS unsigned char* lds, int wid, int lane) const {
        PG8_LAS float* P = (PG8_LAS float*)lds;
        PG8_LAS float* S = (PG8_LAS float*)(lds + 4096);
#pragma unroll
        for (int ai = 0; ai < 2; ++ai)
#pragma unroll
            for (int m = 0; m < 4; ++m) { float s = 0.f;
#pragma unroll
                for (int bj = 0; bj < 2; ++bj)
#pragma unroll
                    for (int n = 0; n < 2; ++n) { const f32x4 x = acc[ai][bj][m][n]; s += (x[0] * x[0] + x[1] * x[1]) + (x[2] * x[2] + x[3] * x[3]); }
                s += __shfl_xor(s, 16); s += __shfl_xor(s, 32);
                if (fq == 0) P[(ai * HALF + wr * 64 + m * 16 + fr) * 4 + wc] = s; }
        asm volatile("s_waitcnt lgkmcnt(0)" ::: "memory"); __builtin_amdgcn_s_barrier(); asm volatile("" ::: "memory");
        const int row = wid * 32 + (lane & 31);
        if (lane < 32) { const float t = (P[row * 4 + 0] + P[row * 4 + 1]) + (P[row * 4 + 2] + P[row * 4 + 3]);
            __hip_atomic_store((unsigned*)slots + ((size_t)(u.pm * BM + row) * 4 + u.pn), __builtin_bit_cast(unsigned, t), __ATOMIC_RELAXED, __HIP_MEMORY_SCOPE_AGENT); }
        asm volatile("s_waitcnt vmcnt(0)" ::: "memory");
        if (lane == 0) __hip_atomic_fetch_add(cnt + 64 * u.pm, 1u, __ATOMIC_RELAXED, __HIP_MEMORY_SCOPE_AGENT);
        if (wid == 0) { unsigned sp = 0;
            while ((unsigned)__builtin_amdgcn_readfirstlane(__hip_atomic_load(cnt + 64 * u.pm, __ATOMIC_RELAXED, __HIP_MEMORY_SCOPE_AGENT)) < 32u) { __builtin_amdgcn_s_sleep(2); if (++sp > (1u << 20)) break; }
            __builtin_amdgcn_fence(__ATOMIC_ACQUIRE, "agent"); }
        asm volatile("s_waitcnt vmcnt(0) lgkmcnt(0)" ::: "memory"); __builtin_amdgcn_s_barrier(); asm volatile("" ::: "memory");
        if (lane < 32) { const unsigned* sl = (const unsigned*)slots + (size_t)(u.pm * BM + row) * 4; float t = 0.f;
#pragma unroll
            for (int k = 0; k < 4; ++k) t += __builtin_bit_cast(float, __hip_atomic_load(sl + k, __ATOMIC_RELAXED, __HIP_MEMORY_SCOPE_AGENT));
            S[row] = 1.0f / sqrtf(t * (1.0f / 1024.0f) + eps); }
        asm volatile("s_waitcnt lgkmcnt(0)" ::: "memory"); __builtin_amdgcn_s_barrier(); asm volatile("" ::: "memory");
        const int col0 = u.pn * BM + wc * 32 + 4 * fq;
#pragma unroll
        for (int bj = 0; bj < 2; ++bj)
#pragma unroll
            for (int n = 0; n < 2; ++n) { const f32x4 gw = *(const f32x4*)(gate + col0 + bj * HALF + n * 16) * *(const f32x4*)(w + col0 + bj * HALF + n * 16);
#pragma unroll
                for (int ai = 0; ai < 2; ++ai)
#pragma unroll
                    for (int m = 0; m < 4; ++m) { const int r = ai * HALF + wr * 64 + m * 16 + fr; const float rs = S[r]; const size_t off = (size_t)(u.pm * BM + r) * ldc + col0 + bj * HALF + n * 16;
                        __builtin_nontemporal_store(__builtin_nontemporal_load((const f32x4*)(base + off)) + gw * (acc[ai][bj][m][n] * rs), (f32x4*)(out + off)); if (m & 1) asm volatile("" ::: "memory"); } }
    }
};
}
#ifndef PG8_SP2
#define PG8_SP2 true
#endif
#ifndef PG8_ALIGN
#define PG8_ALIGN true
#endif
namespace attn_body {
using bf16=__hip_bfloat16;
using bf16x8=__attribute__((ext_vector_type(8)))short;
using s16x4=__attribute__((ext_vector_type(4)))short;
using f32x16=__attribute__((ext_vector_type(16)))float;
using u32x4=__attribute__((ext_vector_type(4)))unsigned;
constexpr int D=64,QP=1024,KP=128;
constexpr int NW=8,QBLK=32,QB=QBLK*NW,KVBLK=64;
constexpr int ATTN_UNIT_ROWS=QB;
__device__ __forceinline__ int crow(int r,int hi){return (r&3)+8*(r>>2)+4*hi;}
#define SBAR() __builtin_amdgcn_sched_barrier(0)
__device__ __forceinline__ void cmask(f32x16&p0,f32x16&p1,int jb,int qrel,int hi){
  const float NEG=-INFINITY; int kb=64*jb+4*hi;
  #pragma unroll
  for(int r=0;r<16;++r){int kv=kb+(r&3)+8*(r>>2); if(kv>qrel)p0[r]=NEG; if(kv+32>qrel)p1[r]=NEG;}
}

constexpr int NSLOT=3, SLOTB=8192;
constexpr int LDS_K=0, LDS_V=NSLOT*SLOTB, LDS_WS=2*NSLOT*SLOTB, LDS_OST=LDS_WS+NW*64*4, LDS_BYTES=LDS_OST+NW*4096;
constexpr float C2=0.125f*1.4426950408889634f;
__device__ __forceinline__ void glds16(const void*gsrc,unsigned lds_dst){unsigned keep;
  asm volatile("s_mov_b32 %0, m0\n\ts_mov_b32 m0, %2\n\ts_nop 0\n\tglobal_load_lds_dwordx4 %1, off\n\ts_mov_b32 m0, %0":"=&s"(keep):"v"(gsrc),"s"(lds_dst):"memory");}
__device__ __forceinline__ float max3f(float a,float b,float c){float r;asm("v_max3_f32 %0, %1, %2, %3":"=v"(r):"v"(a),"v"(b),"v"(c));return r;}
__device__ __forceinline__ float max2f(float a,float b){float r;asm("v_max_f32_e32 %0, %1, %2":"=v"(r):"v"(a),"v"(b));return r;}
__device__ __forceinline__ float fadd_s(float a,float b){float r;asm("v_add_f32_e32 %0, %1, %2":"=v"(r):"v"(a),"v"(b));return r;}
__device__ __forceinline__ float fsub_s(float a,float b){float r;asm("v_sub_f32_e32 %0, %1, %2":"=v"(r):"v"(a),"v"(b));return r;}
typedef float f32x2_t __attribute__((ext_vector_type(2))); typedef __bf16 bf16x2_t __attribute__((ext_vector_type(2)));
__device__ __forceinline__ unsigned cvtpk_s(float lo,float hi){f32x2_t v={lo,hi};bf16x2_t b=__builtin_convertvector(v,bf16x2_t);return __builtin_bit_cast(unsigned,b);}
#define WAIT_BAR(N) asm volatile("s_waitcnt vmcnt(" #N ") lgkmcnt(0)\n\ts_barrier":::"memory")

__device__ __forceinline__ void qkt(f32x16&p0,f32x16&p1,const char*Kslot,const bf16x8*qr,const f32x16&negm,int r32,int hi){
  const char*kb=Kslot+hi*1024+r32*16;
  #pragma unroll
  for(int d0=0;d0<4;++d0){
    const bf16x8 b0=*reinterpret_cast<const bf16x8*>(kb+d0*2048);
    const bf16x8 b1=*reinterpret_cast<const bf16x8*>(kb+d0*2048+512);
    if(d0==0){p0=__builtin_amdgcn_mfma_f32_32x32x16_bf16(b0,qr[0],negm,0,0,0);p1=__builtin_amdgcn_mfma_f32_32x32x16_bf16(b1,qr[0],negm,0,0,0);}
    else{p0=__builtin_amdgcn_mfma_f32_32x32x16_bf16(b0,qr[d0],p0,0,0,0);p1=__builtin_amdgcn_mfma_f32_32x32x16_bf16(b1,qr[d0],p1,0,0,0);}}
}
typedef __attribute__((address_space(3))) const char* lds_cptr;
typedef short v4i16_t __attribute__((ext_vector_type(4)));
__device__ __forceinline__ void kload8(bf16x8*kf,lds_cptr kp){
  kf[0]=*(const __attribute__((address_space(3))) bf16x8*)(kp);      kf[1]=*(const __attribute__((address_space(3))) bf16x8*)(kp+512);
  kf[2]=*(const __attribute__((address_space(3))) bf16x8*)(kp+2048); kf[3]=*(const __attribute__((address_space(3))) bf16x8*)(kp+2560);
  kf[4]=*(const __attribute__((address_space(3))) bf16x8*)(kp+4096); kf[5]=*(const __attribute__((address_space(3))) bf16x8*)(kp+4608);
  kf[6]=*(const __attribute__((address_space(3))) bf16x8*)(kp+6144); kf[7]=*(const __attribute__((address_space(3))) bf16x8*)(kp+6656);
}
__device__ __forceinline__ void kload2(bf16x8*kf,lds_cptr kp,int j){ kf[2*j]=*(const __attribute__((address_space(3))) bf16x8*)(kp+j*2048); kf[2*j+1]=*(const __attribute__((address_space(3))) bf16x8*)(kp+j*2048+512); }
__device__ __forceinline__ s16x4 vtr(lds_cptr p){ return __builtin_bit_cast(s16x4,__builtin_amdgcn_ds_read_tr16_b64_v4i16((__attribute__((address_space(3))) v4i16_t*)p)); }
__device__ __forceinline__ float rowmax(const f32x16&p0,const f32x16&p1){
  float a=max3f(p0[0],p0[1],p1[0]),b=max3f(p0[2],p0[3],p1[1]);a=max3f(a,p1[2],p1[3]);
  #pragma unroll
  for(int r=4;r<16;r+=4){a=max3f(a,p0[r],p0[r+1]);b=max3f(b,p0[r+2],p0[r+3]);a=max3f(a,p1[r],p1[r+1]);b=max3f(b,p1[r+2],p1[r+3]);}
  const float m=max2f(a,b);
  auto rr=__builtin_amdgcn_permlane32_swap(__float_as_uint(m),__float_as_uint(m),false,false);
  return max2f(__uint_as_float(rr[0]),__uint_as_float(rr[1]));
}
__device__ __forceinline__ void pv(f32x16*o,int vb,bf16x8 pa0,bf16x8 pa1,bf16x8 pa2,bf16x8 pa3){
  #pragma unroll
  for(int d0=0;d0<2;++d0){s16x4 lo[4],hi[4];
    #pragma unroll
    for(int ks=0;ks<4;++ks){
      asm volatile("ds_read_b64_tr_b16 %0,%1 offset:%c2":"=&v"(lo[ks]):"v"(vb),"i"(d0*4096+ks*1024):"memory");
      asm volatile("ds_read_b64_tr_b16 %0,%1 offset:%c2":"=&v"(hi[ks]):"v"(vb),"i"(d0*4096+ks*1024+512):"memory");}
    asm volatile("s_waitcnt lgkmcnt(0)":::"memory");SBAR();
    #define PK(k) (bf16x8){lo[k][0],lo[k][1],lo[k][2],lo[k][3],hi[k][0],hi[k][1],hi[k][2],hi[k][3]}
    o[d0]=__builtin_amdgcn_mfma_f32_32x32x16_bf16(pa0,PK(0),o[d0],0,0,0);
    o[d0]=__builtin_amdgcn_mfma_f32_32x32x16_bf16(pa1,PK(1),o[d0],0,0,0);
    o[d0]=__builtin_amdgcn_mfma_f32_32x32x16_bf16(pa2,PK(2),o[d0],0,0,0);
    o[d0]=__builtin_amdgcn_mfma_f32_32x32x16_bf16(pa3,PK(3),o[d0],0,0,0);
    #undef PK
  }
}

#ifndef ATTN_STORE16
#define ATTN_STORE16(p,v) (*(u32x4*)(p)=(v))
#endif
template<int THRL,int OP=1024> __device__ __forceinline__ void attn_unit(const bf16*Qb,const bf16*__restrict__ Kh,const bf16*__restrict__ Vh,bf16*Ob,const int NT,char*shm){
  int tid_=threadIdx.x; asm volatile("":"+v"(tid_)); const int tid=tid_,lane=tid&63,r32=lane&31,hi=lane>>5; const int wid=__builtin_amdgcn_readfirstlane(tid>>6);
  const bf16*Qw=Qb+(long)(wid*QBLK)*QP;
  const unsigned lds0=(unsigned)(uintptr_t)shm;
  float*wsf=(float*)(shm+LDS_WS)+wid*64;
  const bf16*ksrc=Kh+(long)lane*KP+wid*8;
  const bf16*vsrc=Vh+(long)(16*(wid&3)+(lane>>2))*KP+(wid>>2)*32+(lane&3)*8;
  const unsigned kdst=lds0+LDS_K+wid*1024, vdst=lds0+LDS_V+wid*1024;
  #define DMA_K(t,slot) glds16(ksrc+(long)(t)*KVBLK*KP,(unsigned)__builtin_amdgcn_readfirstlane(kdst+(slot)))
  #define DMA_V(t,slot) glds16(vsrc+(long)(t)*KVBLK*KP,(unsigned)__builtin_amdgcn_readfirstlane(vdst+(slot)))
  const int vb0=(int)(lds0+LDS_V)+((lane>>4)&1)*32+(lane&3)*8+(4*hi+((lane&15)>>2))*64;
  const char*Kbase=shm+LDS_K; bf16x8 kf[8];
  const lds_cptr shm3=(lds_cptr)shm; const lds_cptr kp0=shm3+LDS_K+hi*1024+r32*16; const lds_cptr vp0=shm3+LDS_V+((lane>>4)&1)*32+(lane&3)*8+(4*hi+((lane&15)>>2))*64;
  DMA_K(0,0);DMA_V(0,0);DMA_K(1,SLOTB);
  bf16x8 qr[4];
  #pragma unroll
  for(int d0=0;d0<4;++d0)qr[d0]=*reinterpret_cast<const bf16x8*>(&Qw[(long)r32*QP+d0*16+hi*8]);
  float mhat=0.f,l_reg=0.f;f32x16 o[2];o[0]=f32x16{};o[1]=f32x16{};f32x16 negm=f32x16{};asm volatile("":"+v"(negm));
  #define CMASK(P0,P1,t) do{}while(0)
  bool resc=false;
  #define START(P0,P1) do{ const float rm=rowmax(P0,P1); resc=false; \
    { const float dl=rm; mhat=fadd_s(mhat,dl); \
      _Pragma("unroll") for(int r=0;r<16;++r){P0[r]=fsub_s(P0[r],dl);P1[r]=fsub_s(P1[r],dl);} \
      _Pragma("unroll") for(int r=0;r<16;++r)negm[r]=-mhat; asm volatile("":"+v"(negm)); } \
    _Pragma("unroll") for(int r=0;r<16;++r)P0[r]=__builtin_amdgcn_exp2f(P0[r]); }while(0)
  #define RESC() do{ if(resc){ asm volatile("s_waitcnt lgkmcnt(0)":::"memory"); \
      _Pragma("unroll") for(int d_=0;d_<2;++d_) _Pragma("unroll") for(int r=0;r<16;++r)o[d_][r]*=wsf[crow(r,hi)]; } }while(0)
  f32x16 pA0,pA1,pB0,pB1;
  int sl_prev=0,sl_cur=0,sl_next=SLOTB;
  #define ROT() do{sl_prev=sl_cur;sl_cur=sl_next;sl_next=(sl_next==(NSLOT-1)*SLOTB)?0:sl_next+SLOTB;}while(0)
  DMA_K(2,2*SLOTB);
  WAIT_BAR(3);
  qkt(pA0,pA1,Kbase,qr,negm,r32,hi);asm volatile("s_nop 15\n\ts_nop 7":"+v"(pA0),"+v"(pA1));CMASK(pA0,pA1,0);
  START(pA0,pA1);
  _Pragma("unroll") for(int r=0;r<16;++r)pA1[r]=__builtin_amdgcn_exp2f(pA1[r]);
  WAIT_BAR(0);
  DMA_K(3,0);DMA_V(1,SLOTB);
  ROT();
  kload8(kf,kp0+sl_cur);
  WAIT_BAR(2);
  s16x4 vlo[8],vhi[8]; u32x4 pw0,pw1,pw2,pw3;
  #define PKW(P,B) cvtpk_s(P[B],P[B+1])
  #define PAF(k) __builtin_bit_cast(bf16x8,pw##k)
  #define VFR(i) (bf16x8){vlo[i][0],vlo[i][1],vlo[i][2],vlo[i][3],vhi[i][0],vhi[i][1],vhi[i][2],vhi[i][3]}
  #define PIN(x) asm volatile("":"+v"(x))
  #define MX3(a,b,c) __builtin_fmaxf(__builtin_fmaxf((a),(b)),(c))
  #define GAPA(MF,A0,A1,A2,A3,W0,W1,PW) do{ MF; sacc+=A0; sacc+=A1; sacc+=A2; sacc+=A3; PIN(sacc); W0; W1; PIN(PW); SBAR(); }while(0)
  #define EX(v) __builtin_amdgcn_exp2f(v)
  #define GAPB(MF,X,B) do{ MF; X[B]=EX(X[B]); X[B+1]=EX(X[B+1]); X[B+2]=EX(X[B+2]); X[B+3]=EX(X[B+3]); PIN(X); SBAR(); }while(0)
  #define VRD(i) do{ vlo[i]=vtr(vp_+(((i)>>2)*4096+((i)&3)*1024)); vhi[i]=vtr(vp_+(((i)>>2)*4096+((i)&3)*1024+512)); }while(0)
  #define KRD(G,j) do{ if(G){ kload2(kf,kp0+sl_next,j); SBAR(); } }while(0)
  #define STEP(C0,C1,P0,P1,t,GK,GV,GL) do{ SBAR(); \
    const lds_cptr vp_=vp0+sl_prev; \
    VRD(0); SBAR(); float sacc=(P0[0]+P0[1]); \
    GAPA(C0=__builtin_amdgcn_mfma_f32_32x32x16_bf16(kf[0],qr[0],negm,0,0,0), P0[2],P0[3],P0[4],P0[5],     pw0[0]=PKW(P0,0), pw0[1]=PKW(P0,2), pw0); \
    VRD(4); SBAR(); GAPA(C1=__builtin_amdgcn_mfma_f32_32x32x16_bf16(kf[1],qr[0],negm,0,0,0), P0[6],P0[7],P0[8],P0[9],     pw0[2]=PKW(P0,4), pw0[3]=PKW(P0,6), pw0); \
    VRD(1); SBAR(); GAPA(C0=__builtin_amdgcn_mfma_f32_32x32x16_bf16(kf[2],qr[1],C0,0,0,0),   P0[10],P0[11],P0[12],P0[13], pw1[0]=PKW(P0,8), pw1[1]=PKW(P0,10), pw1); \
    VRD(5); SBAR(); GAPA(C1=__builtin_amdgcn_mfma_f32_32x32x16_bf16(kf[3],qr[1],C1,0,0,0),   P0[14],P0[15],P1[0],P1[1],   pw1[2]=PKW(P0,12),pw1[3]=PKW(P0,14), pw1); \
    VRD(2); SBAR(); GAPA(C0=__builtin_amdgcn_mfma_f32_32x32x16_bf16(kf[4],qr[2],C0,0,0,0),   P1[2],P1[3],P1[4],P1[5],     pw2[0]=PKW(P1,0), pw2[1]=PKW(P1,2), pw2); \
    VRD(6); SBAR(); GAPA(C1=__builtin_amdgcn_mfma_f32_32x32x16_bf16(kf[5],qr[2],C1,0,0,0),   P1[6],P1[7],P1[8],P1[9],     pw2[2]=PKW(P1,4), pw2[3]=PKW(P1,6), pw2); \
    VRD(3); SBAR(); GAPA(C0=__builtin_amdgcn_mfma_f32_32x32x16_bf16(kf[6],qr[3],C0,0,0,0),   P1[10],P1[11],P1[12],P1[13], pw3[0]=PKW(P1,8), pw3[1]=PKW(P1,10), pw3); \
    VRD(7); SBAR(); GAPA(C1=__builtin_amdgcn_mfma_f32_32x32x16_bf16(kf[7],qr[3],C1,0,0,0),   P1[14],P1[15],0.f,0.f,       pw3[2]=PKW(P1,12),pw3[3]=PKW(P1,14), pw3); \
    l_reg+=sacc; \
    if(GK){DMA_K((t)+3,sl_cur);} if(GV){DMA_V((t)+1,sl_next);} \
    CMASK(C0,C1,t); \
    { float a=MX3(C0[0],C0[1],C1[0]),b=MX3(C0[2],C0[3],C1[1]); a=MX3(a,C1[2],C1[3]); \
      _Pragma("unroll") for(int r=4;r<16;r+=4){a=MX3(a,C0[r],C0[r+1]);b=MX3(b,C0[r+2],C0[r+3]);a=MX3(a,C1[r],C1[r+1]);b=MX3(b,C1[r+2],C1[r+3]);} \
      float rm=__builtin_fmaxf(a,b); { auto rr=__builtin_amdgcn_permlane32_swap(__float_as_uint(rm),__float_as_uint(rm),false,false); rm=__builtin_fmaxf(__uint_as_float(rr[0]),__uint_as_float(rr[1])); } \
      resc=false; \
      if(__builtin_expect(__any(rm>(float)THRL),0)){ const float dl=__builtin_fmaxf(rm,0.f); mhat+=dl; \
        _Pragma("unroll") for(int r=0;r<16;++r){C0[r]-=dl;C1[r]-=dl;} \
        _Pragma("unroll") for(int r=0;r<16;++r)negm[r]=-mhat; asm volatile("":"+v"(negm)); \
        const float f=__builtin_amdgcn_exp2f(-dl); l_reg*=f; if(hi==0)wsf[r32]=f; resc=true; } } \
    SBAR(); \
    GAPB(o[0]=__builtin_amdgcn_mfma_f32_32x32x16_bf16(PAF(0),VFR(0),o[0],0,0,0), C0,0); \
    GAPB(o[1]=__builtin_amdgcn_mfma_f32_32x32x16_bf16(PAF(0),VFR(4),o[1],0,0,0), C0,4); \
    KRD(GL,0); GAPB(o[0]=__builtin_amdgcn_mfma_f32_32x32x16_bf16(PAF(1),VFR(1),o[0],0,0,0), C0,8); \
    KRD(GL,1); GAPB(o[1]=__builtin_amdgcn_mfma_f32_32x32x16_bf16(PAF(1),VFR(5),o[1],0,0,0), C0,12); \
    KRD(GL,2); GAPB(o[0]=__builtin_amdgcn_mfma_f32_32x32x16_bf16(PAF(2),VFR(2),o[0],0,0,0), C1,0); \
    KRD(GL,3); GAPB(o[1]=__builtin_amdgcn_mfma_f32_32x32x16_bf16(PAF(2),VFR(6),o[1],0,0,0), C1,4); \
    GAPB(o[0]=__builtin_amdgcn_mfma_f32_32x32x16_bf16(PAF(3),VFR(3),o[0],0,0,0), C1,8); \
    GAPB(o[1]=__builtin_amdgcn_mfma_f32_32x32x16_bf16(PAF(3),VFR(7),o[1],0,0,0), C1,12); \
    }while(0)
  int t=1;
  #undef CMASK
  #define CMASK(P0,P1,t) do{}while(0)
  for(;t+5<NT;t+=2){
    STEP(pB0,pB1,pA0,pA1,t,true,true,true);     WAIT_BAR(2); RESC(); ROT();
    STEP(pA0,pA1,pB0,pB1,t+1,true,true,true);   WAIT_BAR(2); RESC(); ROT();
  }
  #undef CMASK
  #define CMASK(P0,P1,t) do{}while(0)
  #define ENDW(tt) do{ if((tt)+3<NT){WAIT_BAR(2);} else if((tt)+2<NT){WAIT_BAR(1);} else {WAIT_BAR(0);} }while(0)
  for(;t+1<NT;t+=2){
    STEP(pB0,pB1,pA0,pA1,t,(t+3<NT),(t+1<NT),(t+1<NT));       ENDW(t);   RESC(); ROT();
    STEP(pA0,pA1,pB0,pB1,t+1,(t+4<NT),(t+2<NT),(t+2<NT));     ENDW(t+1); RESC(); ROT();
  }
  STEP(pB0,pB1,pA0,pA1,NT-1,false,false,false); RESC();
  { float sacc=pB0[0]+pB0[1]; _Pragma("unroll") for(int r=2;r<16;++r)sacc+=pB0[r]; _Pragma("unroll") for(int r=0;r<16;++r)sacc+=pB1[r]; l_reg+=sacc;
    pw0=(u32x4){PKW(pB0,0),PKW(pB0,2),PKW(pB0,4),PKW(pB0,6)};pw1=(u32x4){PKW(pB0,8),PKW(pB0,10),PKW(pB0,12),PKW(pB0,14)};pw2=(u32x4){PKW(pB1,0),PKW(pB1,2),PKW(pB1,4),PKW(pB1,6)};pw3=(u32x4){PKW(pB1,8),PKW(pB1,10),PKW(pB1,12),PKW(pB1,14)};
    SBAR(); pv(o,vb0+sl_cur,PAF(0),PAF(1),PAF(2),PAF(3)); }
  #undef PKW
  #undef PAF
  #undef VFR
  #undef PIN
  #undef MX3
  #undef GAPA
  #undef GAPB
  #undef EX
  #undef VRD
  #undef KRD
  #undef STEP
  #undef ENDW
  {auto rr=__builtin_amdgcn_permlane32_swap(__float_as_uint(l_reg),__float_as_uint(l_reg),false,false);l_reg=__uint_as_float(rr[0])+__uint_as_float(rr[1]);}
  if(hi==0)wsf[32+r32]=l_reg;asm volatile("s_waitcnt lgkmcnt(0)":::"memory");
  float rli[16];
  #pragma unroll
  for(int r=0;r<16;++r)rli[r]=__builtin_amdgcn_rcpf(wsf[32+crow(r,hi)]);
  bf16*Ow=Ob+(long)(wid*QBLK)*OP;
  { bf16*stg=(bf16*)(shm+LDS_OST)+wid*2048;
    #pragma unroll
    for(int r=0;r<16;++r){const int orow=crow(r,hi);
      #pragma unroll
      for(int d0=0;d0<2;++d0)stg[orow*64+d0*32+r32]=__float2bfloat16(o[d0][r]*rli[r]);}
    asm volatile("s_waitcnt lgkmcnt(0)":::"memory");
    #pragma unroll
    for(int i=0;i<4;++i){const int row=i*8+(lane>>3),ch=lane&7; const u32x4 v=*(const u32x4*)(stg+row*64+ch*8); ATTN_STORE16(Ow+(long)row*OP+ch*8,v);} }
  asm volatile("s_waitcnt lgkmcnt(0)\n\ts_barrier":::"memory");
  #undef DMA_K
  #undef DMA_V
  #undef CMASK
  #undef START
  #undef RESC
  #undef ROT
}
constexpr int ATTN_LDS_BYTES=LDS_BYTES;
#undef SBAR
#undef WAIT_BAR
}
constexpr int NWAVES = 8;
constexpr int DMODEL = 1024, NBATCH = 8, SEQ = 2048, CTXL = 256, DEPTH = 2;
constexpr int NLAT = NBATCH * SEQ, NCTX = NBATCH * CTXL, MALL = NLAT + NCTX;
constexpr int DFF = 2816, INDIM = 2312, NIN = 2304, P2W = 1792, KVLEN = CTXL + SEQ;
constexpr int NCHUNK = MALL / 128;
constexpr float EPS = 1e-6f;
constexpr float QSCALE = 0.125f * 1.4426950408889634f;
constexpr size_t al256(size_t x) { return (x + 255) & ~(size_t)255; }
constexpr size_t O_CTL = 0, CTL_BYTES = 32768, CTL_PANEL = 16384;
constexpr size_t O_MOD = CTL_BYTES;
constexpr size_t O_DTRAW = O_MOD + al256((size_t)DEPTH * 9 * 6144 * 4);
constexpr size_t O_DTF = O_DTRAW + al256((size_t)MALL * 8 * 4);
constexpr size_t O_DTB = O_DTF + al256((size_t)MALL * 8 * 4);
constexpr size_t O_CD = O_DTB + al256((size_t)MALL * 8 * 4);
constexpr size_t O_W = O_CD + al256((size_t)2 * NCHUNK * 8 * 4);
constexpr size_t WL_IN = 0, WL_OUT = WL_IN + (size_t)NIN * 1024 * 2, WL_GU = WL_OUT + (size_t)1024 * 1024 * 2, WL_D = WL_GU + (size_t)2 * DFF * 1024 * 2, WL_SIZE = WL_D + (size_t)1024 * DFF * 2;
constexpr size_t O_XC = O_W + DEPTH * WL_SIZE;
constexpr size_t O_H = O_XC + (size_t)NCTX * 1024 * 4;
constexpr size_t O_P2 = O_H + (size_t)MALL * 1024 * 2;
constexpr size_t O_Y = O_P2 + (size_t)MALL * P2W * 2;
constexpr size_t O_KN = O_Y + (size_t)MALL * 1024 * 2;
constexpr size_t O_VN = O_KN + (size_t)NBATCH * KVLEN * 128 * 2;
constexpr size_t O_XT = O_VN + (size_t)NBATCH * KVLEN * 128 * 2;
constexpr size_t O_BT = O_XT + (size_t)512 * MALL * 2;
constexpr size_t O_BM = O_BT + (size_t)256 * MALL * 2;
constexpr size_t O_CM = O_BM + (size_t)MALL * 256 * 2;
constexpr size_t O_END = O_CM + (size_t)MALL * 256 * 2;
constexpr size_t O_XS = O_END;
constexpr size_t O_END2 = O_XS + (size_t)NLAT * 4 * 4;
constexpr size_t O_ACT = O_P2;
static_assert(O_ACT + (size_t)MALL * DFF * 2 <= O_KN, "ACT overlay");
static_assert(O_END2 <= ((size_t)256 << 20), "workspace");
static_assert((size_t)2 * NCHUNK * 8 * 64 * 128 * 2 <= (size_t)MALL * 1024 * 2, "S overlay");
constexpr int LDS_BYTES = 147456, RING_BYTES = 131072;

typedef unsigned short bf16;
typedef unsigned v4u __attribute__((ext_vector_type(4)));
typedef unsigned v2u __attribute__((ext_vector_type(2)));
typedef float f32x4 __attribute__((ext_vector_type(4)));
typedef float f32x16 __attribute__((ext_vector_type(16)));
typedef short bf16x8 __attribute__((ext_vector_type(8)));
typedef short s16x4 __attribute__((ext_vector_type(4)));

__device__ __forceinline__ unsigned f2bf(float f) { unsigned u = __builtin_bit_cast(unsigned, f); return (u + 0x7fffu + ((u >> 16) & 1u)) >> 16; }
typedef float f32x2_k __attribute__((ext_vector_type(2))); typedef __bf16 bf16x2_k __attribute__((ext_vector_type(2)));
__device__ __forceinline__ unsigned pk2(float lo, float hi) { f32x2_k v = {lo, hi}; bf16x2_k b = __builtin_convertvector(v, bf16x2_k); return __builtin_bit_cast(unsigned, b); }
__device__ __forceinline__ float sigm(float z) { return __builtin_amdgcn_rcpf(1.0f + __expf(-z)); }
__device__ __forceinline__ float bflo(unsigned w) { return __builtin_bit_cast(float, w << 16); }
__device__ __forceinline__ float bfhi(unsigned w) { return __builtin_bit_cast(float, w & 0xffff0000u); }
__device__ __forceinline__ float bf1(bf16 v) { return __builtin_bit_cast(float, (unsigned)v << 16); }
__device__ __forceinline__ float wave_sum(float v) {
#pragma unroll
    for (int o = 1; o < 64; o <<= 1) v += __shfl_xor(v, o);
    return v;
}
template <int CTRL, int RM> __device__ __forceinline__ float dpp_addf(float v) { const int o = __builtin_amdgcn_update_dpp(0, __builtin_bit_cast(int, v), CTRL, RM, 0xf, false); return v + __builtin_bit_cast(float, o); }
__device__ __forceinline__ float dpp_sum32_last(float v) { v = dpp_addf<0xb1, 0xf>(v); v = dpp_addf<0x4e, 0xf>(v); v = dpp_addf<0x114, 0xf>(v); v = dpp_addf<0x118, 0xf>(v); v = dpp_addf<0x142, 0xa>(v); return v; }
#ifndef OLDSUM
#define OLDSUM 0
#endif
__device__ __forceinline__ float wave_sum_fast(float v) { if (OLDSUM) return wave_sum(v); v = dpp_sum32_last(v); v = dpp_addf<0x143, 0xc>(v); return __builtin_bit_cast(float, __builtin_amdgcn_readlane(__builtin_bit_cast(int, v), 63)); }
__device__ __forceinline__ float dpp_sum8_all(float v) { v = dpp_addf<0xb1, 0xf>(v); v = dpp_addf<0x4e, 0xf>(v); v = dpp_addf<0x141, 0xf>(v); return v; }
__device__ __forceinline__ float dpp_sum16_all(float v) { v = dpp_sum8_all(v); v = dpp_addf<0x140, 0xf>(v); return v; }
__device__ __forceinline__ float wave_incl_scan(float v, int lane) {
#pragma unroll
    for (int o = 1; o < 64; o <<= 1) { const float t = __shfl_up(v, o); if (lane >= o) v += t; }
    return v;
}
__device__ __forceinline__ int crow16(int r, int hi) { return (r & 3) + 8 * (r >> 2) + 4 * hi; }
#define MFMA32(a, b, c) __builtin_amdgcn_mfma_f32_32x32x16_bf16((a), (b), (c), 0, 0, 0)

#define LAS __attribute__((address_space(3)))
#define XB_TMO      128
#define XB_XCNT(j)  (256  + 64 * (j))
#define XB_XSUB(j)  (1280 + 64 * (j))
#define XB_XGEN(j)  (2304 + 64 * (j))
#define XB_TOP      3328
#define XB_TOPGEN   3392
#define XCD_BAR_WORDS 3456
#define XB_SPIN_CAP (1u << 18)

__device__ __forceinline__ unsigned xb_ld(unsigned* p)              { return __hip_atomic_load(p, __ATOMIC_RELAXED, __HIP_MEMORY_SCOPE_AGENT); }
__device__ __forceinline__ unsigned xb_add(unsigned* p, unsigned v) { return __hip_atomic_fetch_add(p, v, __ATOMIC_RELAXED, __HIP_MEMORY_SCOPE_AGENT); }
__device__ __forceinline__ unsigned xb_xcc_id() { return (unsigned)__builtin_amdgcn_s_getreg((3 << 11) | 20) & 0xFu; }
#define XB_SPIN(cond, bar) do { unsigned _sp = 0; while (cond) { __builtin_amdgcn_s_sleep(4); \
    if ((++_sp & 255u) == 0u) { if (xb_ld(&(bar)[XB_TMO])) break; if (_sp > XB_SPIN_CAP) { atomicAdd(&(bar)[XB_TMO], 1u); break; } } } } while (0)

struct XcdBarrier {
    unsigned* bar; unsigned x;
    volatile LAS unsigned* st;
};

__device__ __forceinline__ XcdBarrier xcd_barrier_post(unsigned* bar, volatile LAS unsigned* st) {
    XcdBarrier b; b.bar = bar; b.x = xb_xcc_id(); b.st = st;
    if (threadIdx.x == 0) (void)xb_add(&bar[XB_XCNT(b.x)], 1u);
    return b;
}
__device__ __forceinline__ void xcd_barrier_complete(unsigned* bar, unsigned x, unsigned& nloc, unsigned& nx) {
    const unsigned G = gridDim.x * gridDim.y * gridDim.z;
    unsigned sum, cnt, mine, sp = 0u;
    for (;;) {
        sum = 0u; cnt = 0u; mine = 0u;
#pragma unroll
        for (unsigned j = 0; j < 16; ++j) { const unsigned c = xb_ld(&bar[XB_XCNT(j)]); sum += c; cnt += (c > 0u) ? 1u : 0u; mine = (j == x) ? c : mine; }
        if (sum == G) break;
        __builtin_amdgcn_s_sleep(1);
        if ((++sp & 255u) == 0u) { if (xb_ld(&bar[XB_TMO])) break; if (sp > XB_SPIN_CAP) { atomicAdd(&bar[XB_TMO], 1u); break; } }
    }
    nloc = mine > 0u ? mine : 1u; nx = cnt > 0u ? cnt : 1u;
}

__device__ __forceinline__ void xcd_barrier(const XcdBarrier& b) {
    asm volatile("s_waitcnt vmcnt(0)" ::: "memory");
    __syncthreads();
    if (threadIdx.x == 0) {
        unsigned* bar = b.bar;
        __builtin_amdgcn_s_waitcnt(0);
        unsigned nloc = b.st[0], nx = b.st[1];
        if (nloc == 0u) { xcd_barrier_complete(bar, b.x, nloc, nx); b.st[0] = nloc; b.st[1] = nx; }
        const unsigned old = xb_add(&bar[XB_XSUB(b.x)], 1u);
        const unsigned gen = old / nloc;
        if (old + 1u == (gen + 1u) * nloc) {
            __builtin_amdgcn_fence(__ATOMIC_RELEASE, "agent");
            asm volatile("s_waitcnt vmcnt(0)" ::: "memory");
            const unsigned og = xb_add(&bar[XB_TOP], 1u);
            const unsigned tg = og / nx;
            if (og + 1u == (tg + 1u) * nx) xb_add(&bar[XB_TOPGEN], 1u);
            else XB_SPIN(xb_ld(&bar[XB_TOPGEN]) == tg, bar);
            __builtin_amdgcn_fence(__ATOMIC_ACQUIRE, "agent");
            xb_add(&bar[XB_XGEN(b.x)], 1u);
            asm volatile("s_waitcnt vmcnt(0)" ::: "memory");
        } else {
            XB_SPIN(xb_ld(&bar[XB_XGEN(b.x)]) == gen, bar);
            __builtin_amdgcn_fence(__ATOMIC_ACQUIRE, "agent");
            asm volatile("s_waitcnt vmcnt(0)" ::: "memory");
        }
    }
    __syncthreads();
}

struct Args { const float* in[25]; float* out; unsigned char* ws; };
typedef const __attribute__((address_space(4))) Args* kargp_t;
struct Frame {
    unsigned char* lds; int tid, lane, wave, G, bid;
    kargp_t ap; float* out; unsigned char* ws;
    __device__ __forceinline__ const float* inp(int i) const { kargp_t p = ap; asm volatile("" : "+s"(p)); return (const float*)(const __attribute__((address_space(1))) float*)p->in[i]; }
    __device__ __forceinline__ void fresh() { int t = threadIdx.x; asm volatile("" : "+v"(t)); tid = t; lane = t & 63; wave = __builtin_amdgcn_readfirstlane(t >> 6); }
    __device__ __forceinline__ unsigned char* wsp() const { __attribute__((address_space(1))) unsigned char* p = (__attribute__((address_space(1))) unsigned char*)ws; asm volatile("" : "+s"(p)); return (unsigned char*)p; }
    __device__ __forceinline__ float* outp() const { __attribute__((address_space(1))) float* p = (__attribute__((address_space(1))) float*)out; asm volatile("" : "+s"(p)); return (float*)p; }
};
__device__ __forceinline__ int gu_row(int a) { return 256 * (a >> 7) + (a & 127); }
__device__ __forceinline__ void transpose_item(const float* W, int ldw, int K, int N, bf16* WT, int mode, float* scr, int item, int lane) {
    const int nblk = N / 32, kb = item / nblk, nb = item % nblk, k0 = 64 * kb, n0 = 32 * nb;
#pragma unroll 8
    for (int i = 0; i < 32; ++i) { const int kk = 2 * i + (lane >> 5); scr[kk * 33 + (lane & 31)] = __builtin_nontemporal_load(W + (size_t)(k0 + kk) * ldw + n0 + (lane & 31)); }
    __builtin_amdgcn_s_waitcnt(0xc07f); asm volatile("s_waitcnt lgkmcnt(0)" ::: "memory");
    const int c = lane & 7;
#pragma unroll
    for (int j = 0; j < 4; ++j) { const int n = (lane >> 3) + 8 * j; const float* s = scr + (8 * c) * 33 + n;
        v4u o; o.x = pk2(s[0 * 33], s[1 * 33]); o.y = pk2(s[2 * 33], s[3 * 33]); o.z = pk2(s[4 * 33], s[5 * 33]); o.w = pk2(s[6 * 33], s[7 * 33]);
        const int a = n0 + n; const int drow = mode == 0 ? a : gu_row(a) + (mode == 2 ? 128 : 0);
        *(v4u*)(WT + (size_t)drow * K + k0 + 8 * c) = o; }
    asm volatile("s_waitcnt lgkmcnt(0)" ::: "memory");
}
__device__ __forceinline__ void phase_prologue(Frame& F) {
    F.fresh();
    __syncthreads();
    float* ldsf = (float*)F.lds;
    if (F.bid < 192) {
        const int lyr = F.bid / 96, n0 = (F.bid % 96) * 64;
        float* sc = ldsf;
        float* red = ldsf + 9 * 1024;
        for (int i = F.tid; i < 9 * 1024; i += 512) { const int s = i >> 10, k = i & 1023; const float v = s < 8 ? F.inp(1)[s * 1024 + k] : F.inp(3)[k]; sc[i] = v / (1.0f + __expf(-v)); }
        __syncthreads();
        const int col = F.tid & 63, ks = F.tid >> 6;
        float acc[9];
#pragma unroll
        for (int s = 0; s < 9; ++s) acc[s] = 0.f;
        const float* wp = F.inp(4) + (size_t)lyr * 1024 * 6144 + (size_t)(ks * 128) * 6144 + n0 + col;
#pragma unroll 8
        for (int k = 0; k < 128; ++k) { const float w = __builtin_nontemporal_load(wp + (size_t)k * 6144);
#pragma unroll
            for (int s = 0; s < 9; ++s) acc[s] += sc[s * 1024 + ks * 128 + k] * w; }
#pragma unroll
        for (int s = 0; s < 9; ++s) red[(ks * 9 + s) * 64 + col] = acc[s];
        __syncthreads();
        float* MOD = (float*)(F.wsp() + O_MOD);
        for (int i = F.tid; i < 9 * 64; i += 512) { const int s = i >> 6, c2 = i & 63; float v = F.inp(5)[lyr * 6144 + n0 + c2];
#pragma unroll
            for (int q = 0; q < 8; ++q) v += red[(q * 9 + s) * 64 + c2];
            MOD[((size_t)lyr * 9 + s) * 6144 + n0 + c2] = v; }
        __syncthreads();
    }
    float* scr = ldsf + F.wave * 4096;
    const int gw = F.bid * NWAVES + F.wave, NGW = F.G * NWAVES;
    constexpr int I_IN = 16 * (NIN / 32), I_OUT = 16 * 32, I_G = 16 * (DFF / 32), I_D = (DFF / 64) * 32, I_L = I_IN + I_OUT + 2 * I_G + I_D;
    for (int it = gw; it < DEPTH * I_L; it += NGW) {
        const int l = it / I_L; int r = it % I_L; bf16* wl = (bf16*)(F.wsp() + O_W + (size_t)l * WL_SIZE);
        if (r < I_IN) { transpose_item(F.inp(10) + (size_t)l * 1024 * INDIM, INDIM, 1024, NIN, wl + WL_IN / 2, 0, scr, r, F.lane); continue; } r -= I_IN;
        if (r < I_OUT) { transpose_item(F.inp(21) + (size_t)l * 1024 * 1024, 1024, 1024, 1024, wl + WL_OUT / 2, 0, scr, r, F.lane); continue; } r -= I_OUT;
        if (r < I_G) { transpose_item(F.inp(22) + (size_t)l * 1024 * DFF, DFF, 1024, DFF, wl + WL_GU / 2, 1, scr, r, F.lane); continue; } r -= I_G;
        if (r < I_G) { transpose_item(F.inp(23) + (size_t)l * 1024 * DFF, DFF, 1024, DFF, wl + WL_GU / 2, 2, scr, r, F.lane); continue; } r -= I_G;
        transpose_item(F.inp(24) + (size_t)l * DFF * 1024, 1024, DFF, 1024, wl + WL_D / 2, 0, scr, r, F.lane);
    }
}
__device__ __forceinline__ const float* xsrc_row(Frame& F, bool from_input, int row) {
    if (from_input) return row < NLAT ? F.inp(0) + (size_t)row * 1024 : F.inp(2) + (size_t)(row - NLAT) * 1024;
    return row < NLAT ? F.outp() + (size_t)row * 1024 : (const float*)(F.wsp() + O_XC) + (size_t)(row - NLAT) * 1024;
}
template <bool RESID, bool PRE, bool DT>
__device__ __forceinline__ void phase_rows(Frame& F, int row_lo, int row_hi, int wg_lo, int wg_cnt, bool from_input, int lr, int gidx, int wpost_i, int lp, int shidx, int wpre_i) {
    F.fresh();
    if (F.bid < wg_lo || F.bid >= wg_lo + wg_cnt) return;
    float* wdt = (float*)F.lds;
    if (DT) {
        for (int i = F.tid; i < 1024 * 8; i += 512) wdt[i] = F.inp(10)[(size_t)lp * 1024 * INDIM + (size_t)(i >> 3) * INDIM + NIN + (i & 7)];
        __syncthreads();
    }
    const float* MOD = (const float*)(F.wsp() + O_MOD);
    bf16* H = (bf16*)(F.wsp() + O_H);
    const int gw = (F.bid - wg_lo) * NWAVES + F.wave, NGW = wg_cnt * NWAVES, lane = F.lane;
    const int rpw_full = (row_hi - row_lo + NGW - 1) / NGW;
    f32x4 wpo[4], wpr[4], gm[4], shm_[4], scm[4];
#pragma unroll
    for (int j = 0; j < 4; ++j) { wpo[j] = RESID ? ((const f32x4*)(F.inp(wpost_i) + (size_t)lr * 1024) + lane)[64 * j] : (f32x4){0.f, 0.f, 0.f, 0.f};
        wpr[j] = PRE ? ((const f32x4*)(F.inp(wpre_i) + (size_t)lp * 1024) + lane)[64 * j] : (f32x4){0.f, 0.f, 0.f, 0.f}; gm[j] = shm_[j] = scm[j] = (f32x4){0.f, 0.f, 0.f, 0.f}; }
    int cur_s = -1;
    const int row0 = row_lo + gw * rpw_full;
    const int rpw = row0 >= row_hi ? 0 : (row_hi - row0 < rpw_full ? row_hi - row0 : rpw_full);
    f32x4 v[4], vn[4]; v2u mw[4], mwn[4];
    if (rpw > 0) { const f32x4* xr = (const f32x4*)xsrc_row(F, from_input, row0) + lane;
#pragma unroll
      for (int j = 0; j < 4; ++j) { vn[j] = __builtin_nontemporal_load(xr + 64 * j); if (RESID) mwn[j] = __builtin_nontemporal_load((const v2u*)(H + (size_t)row0 * 1024) + lane + 64 * j); } }
    for (int k = 0; k < rpw; ++k) {
        const int row = row0 + k;
        const int s = row < NLAT ? row / SEQ : 8;
#pragma unroll
        for (int j = 0; j < 4; ++j) { v[j] = vn[j]; if (RESID) mw[j] = mwn[j]; }
        if (k + 1 < rpw) { const f32x4* xr = (const f32x4*)xsrc_row(F, from_input, row + 1) + lane;
#pragma unroll
            for (int j = 0; j < 4; ++j) { vn[j] = __builtin_nontemporal_load(xr + 64 * j); if (RESID) mwn[j] = __builtin_nontemporal_load((const v2u*)(H + (size_t)(row + 1) * 1024) + lane + 64 * j); } }
        if (s != cur_s) { cur_s = s;
#pragma unroll
            for (int j = 0; j < 4; ++j) {
                if (RESID) gm[j] = ((const f32x4*)(MOD + ((size_t)lr * 9 + s) * 6144 + gidx * 1024) + lane)[64 * j];
                if (PRE) { shm_[j] = ((const f32x4*)(MOD + ((size_t)lp * 9 + s) * 6144 + shidx * 1024) + lane)[64 * j]; scm[j] = ((const f32x4*)(MOD + ((size_t)lp * 9 + s) * 6144 + (shidx + 1) * 1024) + lane)[64 * j]; } } }
        if (RESID) {
            f32x4 m[4]; float ss = 0.f;
#pragma unroll
            for (int j = 0; j < 4; ++j) { const v2u w = mw[j]; m[j] = (f32x4){bflo(w.x), bfhi(w.x), bflo(w.y), bfhi(w.y)}; ss += (m[j].x * m[j].x + m[j].y * m[j].y) + (m[j].z * m[j].z + m[j].w * m[j].w); }
            const float rstd = 1.0f / sqrtf(wave_sum_fast(ss) * (1.0f / 1024.0f) + EPS);
            float* xo = (row < NLAT ? F.outp() + (size_t)row * 1024 : (float*)(F.wsp() + O_XC) + (size_t)(row - NLAT) * 1024);
#pragma unroll
            for (int j = 0; j < 4; ++j) { v[j] = v[j] + gm[j] * (m[j] * rstd * wpo[j]); __builtin_nontemporal_store(v[j], (f32x4*)xo + lane + 64 * j); }
        }
        if (PRE) {
            float ss = 0.f;
#pragma unroll
            for (int j = 0; j < 4; ++j) ss += (v[j].x * v[j].x + v[j].y * v[j].y) + (v[j].z * v[j].z + v[j].w * v[j].w);
            const float rstd = 1.0f / sqrtf(wave_sum_fast(ss) * (1.0f / 1024.0f) + EPS);
            float dacc[8];
#pragma unroll
            for (int e = 0; e < 8; ++e) dacc[e] = 0.f;
            v2u* ho = (v2u*)(H + (size_t)row * 1024) + lane;
#pragma unroll
            for (int j = 0; j < 4; ++j) {
                const f32x4 h = (v[j] * rstd * wpr[j]) * (scm[j] + 1.0f) + shm_[j];
                v2u o; o.x = pk2(h.x, h.y); o.y = pk2(h.z, h.w); ho[64 * j] = o;
                if (DT) {
#pragma unroll
                    for (int e = 0; e < 4; ++e) { const f32x4* wk = (const f32x4*)(wdt + (size_t)(4 * lane + 256 * j + e) * 8); const f32x4 w0 = wk[0], w1 = wk[1];
                        dacc[0] += h[e] * w0.x; dacc[1] += h[e] * w0.y; dacc[2] += h[e] * w0.z; dacc[3] += h[e] * w0.w; dacc[4] += h[e] * w1.x; dacc[5] += h[e] * w1.y; dacc[6] += h[e] * w1.z; dacc[7] += h[e] * w1.w; } }
            }
            if (DT) {
                float r4[4];
#pragma unroll
                for (int e = 0; e < 4; ++e) { const float keep = lane < 32 ? dacc[e] : dacc[e + 4], send = lane < 32 ? dacc[e + 4] : dacc[e];
                    r4[e] = dpp_sum32_last(keep + __shfl_xor(send, 32)); }
                if ((lane & 31) == 31) { float* dr = (float*)(F.wsp() + O_DTRAW) + (size_t)row * 8 + (lane >> 5) * 4; *(f32x4*)dr = (f32x4){r4[0], r4[1], r4[2], r4[3]}; }
            }
        }
    }
    if (DT) __syncthreads();
}
__device__ __forceinline__ void qk_norm_rope(const v2u a1, const v2u a2, const float* nw, int d0, bool rope, int t, float scale, v2u& o1, v2u& o2) {
    float x1[4] = {bflo(a1.x), bfhi(a1.x), bflo(a1.y), bfhi(a1.y)}, x2[4] = {bflo(a2.x), bfhi(a2.x), bflo(a2.y), bfhi(a2.y)};
    float ss = 0.f;
#pragma unroll
    for (int e = 0; e < 4; ++e) ss += x1[e] * x1[e] + x2[e] * x2[e];
    ss = dpp_sum8_all(ss);
    const float rstd = 1.0f / sqrtf(ss * (1.0f / 64.0f) + EPS);
    float r1[4], r2[4];
#pragma unroll
    for (int e = 0; e < 4; ++e) {
        const float y1 = x1[e] * rstd * nw[d0 + e], y2 = x2[e] * rstd * nw[32 + d0 + e];
        if (rope) {
            const int i = d0 + e;
            const float pos = (float)(i < 16 ? (t >> 6) : (t & 63));
            const float freq = exp2f(-(float)(i & 15) * (13.287712379549449f / 16.0f));
            const float ang = pos * freq;
            float rev = ang * 0.15915494309189535f; rev = rev - floorf(rev);
            const float sn = __builtin_amdgcn_sinf(rev), cs = __builtin_amdgcn_cosf(rev);
            r1[e] = (y1 * cs - y2 * sn) * scale; r2[e] = (y1 * sn + y2 * cs) * scale;
        } else { r1[e] = y1 * scale; r2[e] = y2 * scale; }
    }
    o1.x = pk2(r1[0], r1[1]); o1.y = pk2(r1[2], r1[3]); o2.x = pk2(r2[0], r2[1]); o2.y = pk2(r2[2], r2[3]);
}
__device__ __forceinline__ void phase_post(Frame& F, int l) {
    F.fresh();
    bf16* Y = (bf16*)(F.wsp() + O_Y); const bf16* P2 = (const bf16*)(F.wsp() + O_P2);
    bf16* KN = (bf16*)(F.wsp() + O_KN); bf16* VN = (bf16*)(F.wsp() + O_VN);
    const int gw = F.bid * NWAVES + F.wave, NGW = F.G * NWAVES, lane = F.lane;
    const float* qn = F.inp(11) + l * 64; const float* kn = F.inp(12) + l * 64;
    const int hd = lane >> 3, d0 = (lane & 7) * 4, hk = hd & 1;
    const float* DTR = (const float*)(F.wsp() + O_DTRAW);
    struct PostIn { v2u q1, q2, k1, k2; v4u v; float dt; };
#define POST_LOAD(P, row_) do { if ((row_) < MALL) { const bf16* qp_ = Y + (size_t)(row_) * 1024 + hd * 64 + d0; P.q1 = *(const v2u*)qp_; P.q2 = *(const v2u*)(qp_ + 32); \
        const bf16* kp_ = P2 + (size_t)(row_) * P2W + hk * 64 + d0; P.k1 = __builtin_nontemporal_load((const v2u*)kp_); P.k2 = __builtin_nontemporal_load((const v2u*)(kp_ + 32)); \
        P.v = __builtin_nontemporal_load((const v4u*)(P2 + (size_t)(row_) * P2W + 128 + (lane & 15) * 8)); P.dt = DTR[(size_t)(row_) * 8 + (lane & 7)]; } } while (0)
#define POST_ROW(P, row_) do { if ((row_) < MALL) { const int rw_ = (row_); const bool lat = rw_ < NLAT; int b, t, pos; \
        if (lat) { b = rw_ >> 11; t = rw_ & 2047; pos = CTXL + t; } else { const int rr = rw_ - NLAT; b = rr >> 8; t = rr & 255; pos = t; } \
        { v2u o1, o2; qk_norm_rope(P.q1, P.q2, qn, d0, lat, t, QSCALE, o1, o2); bf16* qp = Y + (size_t)rw_ * 1024 + hd * 64 + d0; *(v2u*)qp = o1; *(v2u*)(qp + 32) = o2; } \
        { v2u o1, o2; qk_norm_rope(P.k1, P.k2, kn, d0, lat, t, 1.0f, o1, o2); \
          if (lane < 16) { bf16* ko = KN + ((size_t)b * KVLEN + pos) * 128 + hk * 64 + d0; *(v2u*)ko = o1; *(v2u*)(ko + 32) = o2; } } \
        if (lane >= 16 && lane < 32) *(v4u*)(VN + ((size_t)b * KVLEN + pos) * 128 + (lane - 16) * 8) = P.v; \
        if (lane >= 32 && lane < 48) { const int jj = lane - 32, hh = jj & 7, dir = jj >> 3; \
            const float raw = P.dt + F.inp(dir ? 16 : 15)[l * 8 + hh]; \
            const float sp = raw > 20.f ? raw : log1pf(expf(raw)); \
            ((float*)(F.wsp() + (dir ? O_DTB : O_DTF)))[(size_t)rw_ * 8 + hh] = sp; } } } while (0)
    bf16* XT = (bf16*)(F.wsp() + O_XT); bf16* BT = (bf16*)(F.wsp() + O_BT); bf16* BMp = (bf16*)(F.wsp() + O_BM); bf16* CMp = (bf16*)(F.wsp() + O_CM);
    const float* cw = F.inp(13) + (size_t)l * 5 * 1024; const float* cb = F.inp(14) + (size_t)l * 1024;
    const int ch = 8 * (F.tid & 127), sub = F.tid >> 7;
    float wv[5][8], bv[8];
#pragma unroll
    for (int k = 0; k < 5; ++k) { const f32x4 a = *(const f32x4*)(cw + k * 1024 + ch), b = *(const f32x4*)(cw + k * 1024 + ch + 4);
#pragma unroll
        for (int e = 0; e < 4; ++e) { wv[k][e] = a[e]; wv[k][4 + e] = b[e]; } }
    { const f32x4 a = *(const f32x4*)(cb + ch), b = *(const f32x4*)(cb + ch + 4);
#pragma unroll
      for (int e = 0; e < 4; ++e) { bv[e] = a[e]; bv[4 + e] = b[e]; } }
    PostIn p0, p1, p2;
    POST_LOAD(p0, gw); POST_LOAD(p1, gw + NGW);
    int arow = gw;
    for (int blk = F.bid; blk < MALL / 32 || arow < MALL; blk += F.G) {
        const bool cv = blk < MALL / 32;
        const int r0 = blk * 32;
        const int seglen = r0 < NLAT ? SEQ : CTXL; const int segbase = r0 < NLAT ? (r0 & ~(SEQ - 1)) : NLAT + ((r0 - NLAT) & ~(CTXL - 1));
        const bool lo_ok = r0 > segbase, hi_ok = r0 + 32 < segbase + seglen;
        const int k0 = 8 * sub;
        v4u un[12];
        if (cv) { const bf16* src = P2 + (size_t)(r0 + k0) * P2W + 768 + ch;
#pragma unroll
            for (int j = 0; j < 12; ++j) { const int kk = k0 - 2 + j; un[j] = ((kk >= 0 || lo_ok) && (kk < 32 || hi_ok)) ? *(const v4u*)(src + (ptrdiff_t)(j - 2) * P2W) : (v4u){0u, 0u, 0u, 0u}; } }
        else {
#pragma unroll
            for (int j = 0; j < 12; ++j) un[j] = (v4u){0u, 0u, 0u, 0u}; }
        POST_LOAD(p2, arow + 2 * NGW); POST_ROW(p0, arow);
        POST_LOAD(p0, arow + 3 * NGW); POST_ROW(p1, arow + NGW);
        POST_LOAD(p1, arow + 4 * NGW); POST_ROW(p2, arow + 2 * NGW);
        arow += 3 * NGW;
        if (cv) {
            unsigned pk[8][4];
#pragma unroll
            for (int j = 0; j < 8; ++j) {
                float y[8];
#pragma unroll
                for (int e = 0; e < 8; ++e) y[e] = bv[e];
#pragma unroll
                for (int k = 0; k < 5; ++k) { const v4u u = un[j + k]; const unsigned uu[4] = {u.x, u.y, u.z, u.w};
#pragma unroll
                    for (int e = 0; e < 4; ++e) { y[2 * e] += wv[k][2 * e] * bflo(uu[e]); y[2 * e + 1] += wv[k][2 * e + 1] * bfhi(uu[e]); } }
                unsigned o[8];
#pragma unroll
                for (int e = 0; e < 8; ++e) { const float t = y[e] * sigm(y[e]); o[e] = f2bf(t); }
                if (ch >= 512) { const v4u tv = (v4u){o[0] | (o[1] << 16), o[2] | (o[3] << 16), o[4] | (o[5] << 16), o[6] | (o[7] << 16)};
                    bf16* dM = ch < 768 ? BMp + (size_t)(r0 + k0 + j) * 256 + (ch - 512) : CMp + (size_t)(r0 + k0 + j) * 256 + (ch - 768); *(v4u*)dM = tv; }
#pragma unroll
                for (int e = 0; e < 8; ++e) { if (j & 1) pk[e][j >> 1] |= o[e] << 16; else pk[e][j >> 1] = o[e]; }
            }
            if (ch < 768) { bf16* dT = (ch < 512 ? XT + (size_t)ch * MALL : BT + (size_t)(ch - 512) * MALL) + r0 + k0;
#pragma unroll
                for (int e = 0; e < 8; ++e) *(v4u*)(dT + (size_t)e * MALL) = (v4u){pk[e][0], pk[e][1], pk[e][2], pk[e][3]}; }
        }
    }
#undef POST_LOAD
#undef POST_ROW
}
__device__ __forceinline__ void phase_ssd1(Frame& F, int l) {
    F.fresh();
    const int lane = F.lane, tid = F.tid, hl = F.wave & 3, pt = F.wave >> 2, r32 = lane & 31, hi = lane >> 5;
    constexpr int PT = 136;
    bf16* Bs = (bf16*)F.lds; bf16* Xs = Bs + 128 * PT;
    float* wtab = (float*)(F.lds + (128 + 256) * PT * 2) + F.wave * 256;
    const bf16* XT = (const bf16*)(F.wsp() + O_XT); const bf16* BT = (const bf16*)(F.wsp() + O_BT);
    const float* DTF = (const float*)(F.wsp() + O_DTF); const float* DTB = (const float*)(F.wsp() + O_DTB);
    bf16* S = (bf16*)(F.wsp() + O_H); float* CD = (float*)(F.wsp() + O_CD);
    for (int u = F.bid; u < 2 * NCHUNK; u += F.G) {
        const int c = u >> 1, g = u & 1, h = 4 * g + hl;
        const size_t rb = (size_t)c * 128;
        v4u tx[8], tb[4];
#pragma unroll
        for (int q = 0; q < 8; ++q) { const int idx = tid + 512 * q; tx[q] = *(const v4u*)(XT + (size_t)(g * 256 + (idx >> 4)) * MALL + rb + (idx & 15) * 8); }
#pragma unroll
        for (int q = 0; q < 4; ++q) { const int idx = tid + 512 * q; tb[q] = *(const v4u*)(BT + (size_t)(g * 128 + (idx >> 4)) * MALL + rb + (idx & 15) * 8); }
        const float Af = -expf(F.inp(17)[l * 8 + h]), Ab = -expf(F.inp(18)[l * 8 + h]);
        { const float d0 = DTF[(rb + 2 * lane) * 8 + h], d1 = DTF[(rb + 2 * lane + 1) * 8 + h]; const float a0 = d0 * Af, a1 = d1 * Af;
          const float inc = wave_incl_scan(a0 + a1, lane); const float tot = __shfl(inc, 63); const float c1 = inc, c0 = inc - a1;
          wtab[2 * lane] = __expf(tot - c0) * d0; wtab[2 * lane + 1] = __expf(tot - c1) * d1;
          if (lane == 0 && pt == 0) CD[(0 * NCHUNK + c) * 8 + h] = __expf(tot); }
        { const float d0 = DTB[(rb + 2 * lane) * 8 + h], d1 = DTB[(rb + 2 * lane + 1) * 8 + h]; const float a0 = d0 * Ab, a1 = d1 * Ab;
          const float inc = wave_incl_scan(a0 + a1, lane); const float tot = __shfl(inc, 63); const float e0 = inc - a0 - a1, e1 = inc - a1;
          wtab[128 + 2 * lane] = __expf(e0) * d0; wtab[128 + 2 * lane + 1] = __expf(e1) * d1;
          if (lane == 0 && pt == 0) CD[(1 * NCHUNK + c) * 8 + h] = __expf(tot); }
#pragma unroll
        for (int q = 0; q < 8; ++q) { const int idx = tid + 512 * q; *(v4u*)(Xs + (idx >> 4) * PT + (idx & 15) * 8) = tx[q]; }
#pragma unroll
        for (int q = 0; q < 4; ++q) { const int idx = tid + 512 * q; *(v4u*)(Bs + (idx >> 4) * PT + (idx & 15) * 8) = tb[q]; }
        __syncthreads();
        const bf16* xrow = Xs + (64 * hl + 32 * pt + r32) * PT + 8 * hi;
        const bf16* brow = Bs + r32 * PT + 8 * hi;
#pragma unroll 1
        for (int dir = 0; dir < 2; ++dir) {
            f32x16 acc[4];
#pragma unroll
            for (int b = 0; b < 4; ++b)
#pragma unroll
                for (int r = 0; r < 16; ++r) acc[b][r] = 0.f;
#pragma unroll 2
            for (int ks = 0; ks < 8; ++ks) {
                const f32x4 w0 = *(const f32x4*)(wtab + dir * 128 + 16 * ks + 8 * hi), w1 = *(const f32x4*)(wtab + dir * 128 + 16 * ks + 8 * hi + 4);
                const v4u raw = *(const v4u*)(xrow + 16 * ks);
                v4u o; o.x = pk2(bflo(raw.x) * w0.x, bfhi(raw.x) * w0.y); o.y = pk2(bflo(raw.y) * w0.z, bfhi(raw.y) * w0.w); o.z = pk2(bflo(raw.z) * w1.x, bfhi(raw.z) * w1.y); o.w = pk2(bflo(raw.w) * w1.z, bfhi(raw.w) * w1.w);
                const bf16x8 af = __builtin_bit_cast(bf16x8, o);
#pragma unroll
                for (int nt = 0; nt < 4; ++nt) acc[nt] = MFMA32(af, *(const bf16x8*)(brow + 32 * nt * PT + 16 * ks), acc[nt]);
            }
            bf16* so = S + ((size_t)(dir * NCHUNK + c) * 8 + h) * 8192 + (size_t)(32 * pt) * 128 + r32;
#pragma unroll
            for (int nt = 0; nt < 4; ++nt)
#pragma unroll
                for (int r = 0; r < 16; ++r) so[crow16(r, hi) * 128 + 32 * nt] = (bf16)f2bf(acc[nt][r]);
        }
        __syncthreads();
    }
}
__device__ __forceinline__ void phase_ssd2(Frame& F) {
    F.fresh();
    bf16* S = (bf16*)(F.wsp() + O_H); const float* CD = (const float*)(F.wsp() + O_CD);
    for (int gidx = F.bid * 512 + F.tid; gidx < 128 * 1024; gidx += F.G * 512) {
        const int seq = gidx >> 10, e8 = gidx & 1023, b = seq >> 4, dir = (seq >> 3) & 1, h = seq & 7;
        v4u raw[18];
#pragma unroll
        for (int s = 0; s < 18; ++s) { const int c = s < 2 ? 128 + 2 * b + (dir ? 1 - s : s) : 16 * b + (dir ? 17 - s : s - 2);
            raw[s] = __builtin_nontemporal_load((const v4u*)(S + ((size_t)(dir * NCHUNK + c) * 8 + h) * 8192 + e8 * 8)); }
        float st[8];
#pragma unroll
        for (int e = 0; e < 8; ++e) st[e] = 0.f;
#pragma unroll
        for (int s = 0; s < 18; ++s) { const int c = s < 2 ? 128 + 2 * b + (dir ? 1 - s : s) : 16 * b + (dir ? 17 - s : s - 2);
            const float d = CD[(dir * NCHUNK + c) * 8 + h];
            v4u o; o.x = pk2(st[0], st[1]); o.y = pk2(st[2], st[3]); o.z = pk2(st[4], st[5]); o.w = pk2(st[6], st[7]);
            *(v4u*)(S + ((size_t)(dir * NCHUNK + c) * 8 + h) * 8192 + e8 * 8) = o;
            const unsigned u[4] = {raw[s].x, raw[s].y, raw[s].z, raw[s].w};
#pragma unroll
            for (int e = 0; e < 4; ++e) { st[2 * e] = st[2 * e] * d + bflo(u[e]); st[2 * e + 1] = st[2 * e + 1] * d + bfhi(u[e]); } }
    }
}
__device__ __forceinline__ void phase_ssd12(Frame& F, int l) {
    F.fresh();
    if (F.bid >= 128) return;
    const int lane = F.lane, r32 = lane & 31, hi = lane >> 5, pt = F.wave >> 2, nt = F.wave & 3;
    const int b = F.bid >> 4, dir = (F.bid >> 3) & 1, h = F.bid & 7, g = h >> 2;
    float* wtab = (float*)F.lds + F.wave * 128;
    const bf16* XTr = (const bf16*)(F.wsp() + O_XT) + (size_t)(h * 64 + 32 * pt + r32) * MALL + 8 * hi;
    const bf16* BTr = (const bf16*)(F.wsp() + O_BT) + (size_t)(g * 128 + 32 * nt + r32) * MALL + 8 * hi;
    const float* DT = (const float*)(F.wsp() + (dir ? O_DTB : O_DTF)) + h;
    bf16* S = (bf16*)(F.wsp() + O_H);
    const float Aa = -expf(F.inp(dir ? 18 : 17)[l * 8 + h]);
    f32x16 acc;
#pragma unroll
    for (int r = 0; r < 16; ++r) acc[r] = 0.f;
#define S12_CHUNK(s_) ((s_) < 2 ? 128 + 2 * b + (dir ? 1 - (s_) : (s_)) : 16 * b + (dir ? 17 - (s_) : (s_) - 2))
#define S12_LOAD(A_, B_, d0_, d1_, c_) do { const size_t rb_ = (size_t)(c_) * 128; \
        _Pragma("unroll") for (int ks = 0; ks < 8; ++ks) { A_[ks] = *(const v4u*)(XTr + rb_ + 16 * ks); B_[ks] = *(const bf16x8*)(BTr + rb_ + 16 * ks); } \
        d0_ = DT[(rb_ + 2 * lane) * 8]; d1_ = DT[(rb_ + 2 * lane + 1) * 8]; } while (0)
#define S12_STEP(A_, B_, d0_, d1_, c_) do { \
        const float a0 = d0_ * Aa, a1 = d1_ * Aa; const float inc = wave_incl_scan(a0 + a1, lane); const float tot = __shfl(inc, 63); \
        if (dir == 0) { wtab[2 * lane] = __expf(tot - (inc - a1)) * d0_; wtab[2 * lane + 1] = __expf(tot - inc) * d1_; } \
        else { wtab[2 * lane] = __expf(inc - a0 - a1) * d0_; wtab[2 * lane + 1] = __expf(inc - a1) * d1_; } \
        const float dec = __expf(tot); \
        bf16* so = S + ((size_t)(dir * NCHUNK + (c_)) * 8 + h) * 8192 + (size_t)(32 * pt) * 128 + 32 * nt + r32; \
        _Pragma("unroll") for (int r = 0; r < 16; ++r) { so[crow16(r, hi) * 128] = (bf16)f2bf(acc[r]); acc[r] *= dec; } \
        asm volatile("s_waitcnt lgkmcnt(0)" ::: "memory"); \
        _Pragma("unroll") for (int ks = 0; ks < 8; ++ks) { const f32x4 w0 = *(const f32x4*)(wtab + 16 * ks + 8 * hi), w1 = *(const f32x4*)(wtab + 16 * ks + 8 * hi + 4); const v4u raw = A_[ks]; \
            v4u o; o.x = pk2(bflo(raw.x) * w0.x, bfhi(raw.x) * w0.y); o.y = pk2(bflo(raw.y) * w0.z, bfhi(raw.y) * w0.w); o.z = pk2(bflo(raw.z) * w1.x, bfhi(raw.z) * w1.y); o.w = pk2(bflo(raw.w) * w1.z, bfhi(raw.w) * w1.w); \
            acc = MFMA32(__builtin_bit_cast(bf16x8, o), B_[ks], acc); } \
        asm volatile("s_waitcnt lgkmcnt(0)" ::: "memory"); __builtin_amdgcn_sched_barrier(0); } while (0)
    v4u A0[8], A1[8]; bf16x8 B0[8], B1[8]; float e0, e1, f0, f1;
    S12_LOAD(A0, B0, e0, e1, S12_CHUNK(0));
#pragma unroll 1
    for (int sp = 0; sp < 9; ++sp) {
        const int s0 = 2 * sp, c0 = S12_CHUNK(s0), c1 = S12_CHUNK(s0 + 1), s2 = s0 + 2 < 18 ? s0 + 2 : 17, c2 = S12_CHUNK(s2);
        S12_LOAD(A1, B1, f0, f1, c1);
        S12_STEP(A0, B0, e0, e1, c0);
        S12_LOAD(A0, B0, e0, e1, c2);
        S12_STEP(A1, B1, f0, f1, c1);
    }
#undef S12_CHUNK
#undef S12_LOAD
#undef S12_STEP
}
__device__ __forceinline__ void ssd3_unit(Frame& F, int l, int c) {
    F.fresh();
    const int lane = F.lane, h = F.wave, g = h >> 2, r32 = lane & 31, hi = lane >> 5;
    float* tab = (float*)F.lds + h * 512;
    float* ssqb = (float*)F.lds + 8 * 512;
    const bf16* XT = (const bf16*)(F.wsp() + O_XT); const bf16* BMp = (const bf16*)(F.wsp() + O_BM); const bf16* CMp = (const bf16*)(F.wsp() + O_CM);
    const bf16* P2 = (const bf16*)(F.wsp() + O_P2); bf16* Y = (bf16*)(F.wsp() + O_Y);
    const float* DTF = (const float*)(F.wsp() + O_DTF); const float* DTB = (const float*)(F.wsp() + O_DTB);
    const bf16* S = (const bf16*)(F.wsp() + O_H);
    const float Af = -expf(F.inp(17)[l * 8 + h]), Ab = -expf(F.inp(18)[l * 8 + h]);
    const float dsk = F.inp(19)[l * 8 + h];
    const size_t rb = (size_t)c * 128;
    { const float d0 = DTF[(rb + 2 * lane) * 8 + h], d1 = DTF[(rb + 2 * lane + 1) * 8 + h]; const float a0 = d0 * Af, a1 = d1 * Af;
      const float inc = wave_incl_scan(a0 + a1, lane);
      tab[2 * lane] = inc - a1; tab[2 * lane + 1] = inc; tab[256 + 2 * lane] = d0; tab[256 + 2 * lane + 1] = d1; }
    { const float d0 = DTB[(rb + 2 * lane) * 8 + h], d1 = DTB[(rb + 2 * lane + 1) * 8 + h]; const float a0 = d0 * Ab, a1 = d1 * Ab;
      const float inc = wave_incl_scan(a0 + a1, lane); const float tot = __shfl(inc, 63);
      tab[128 + 2 * lane] = tot - (inc - a0 - a1); tab[128 + 2 * lane + 1] = tot - (inc - a1); tab[384 + 2 * lane] = d0; tab[384 + 2 * lane + 1] = d1; }
    asm volatile("s_waitcnt lgkmcnt(0)" ::: "memory");
    const float* cumf = tab; const float* rcum = tab + 128; const float* dtf = tab + 256; const float* dtb = tab + 384;
    const bf16* Hf = S + ((size_t)(0 * NCHUNK + c) * 8 + h) * 8192; const bf16* Hb = S + ((size_t)(1 * NCHUNK + c) * 8 + h) * 8192;
    const float nw0 = F.inp(20)[l * 512 + h * 64 + r32], nw1 = F.inp(20)[l * 512 + h * 64 + 32 + r32];
#pragma unroll 1
    for (int ib = 0; ib < 4; ++ib) {
        bf16x8 cfr[8];
#pragma unroll
        for (int ks = 0; ks < 8; ++ks) cfr[ks] = *(const bf16x8*)(CMp + (rb + 32 * ib + r32) * 256 + g * 128 + 16 * ks + 8 * hi);
        f32x16 ya[2];
#pragma unroll
        for (int pt = 0; pt < 2; ++pt) {
            f32x16 t;
#pragma unroll
            for (int r = 0; r < 16; ++r) t[r] = 0.f;
#pragma unroll
            for (int ks = 0; ks < 8; ++ks) t = MFMA32(cfr[ks], *(const bf16x8*)(Hf + (32 * pt + r32) * 128 + 16 * ks + 8 * hi), t);
#pragma unroll
            for (int r = 0; r < 16; ++r) ya[pt][r] = t[r] * __expf(cumf[32 * ib + crow16(r, hi)]);
            __builtin_amdgcn_sched_barrier(0);
#pragma unroll
            for (int r = 0; r < 16; ++r) t[r] = 0.f;
#pragma unroll
            for (int ks = 0; ks < 8; ++ks) t = MFMA32(cfr[ks], *(const bf16x8*)(Hb + (32 * pt + r32) * 128 + 16 * ks + 8 * hi), t);
#pragma unroll
            for (int r = 0; r < 16; ++r) ya[pt][r] += t[r] * __expf(rcum[32 * ib + crow16(r, hi)]);
            __builtin_amdgcn_sched_barrier(0);
        }
        const float cif = cumf[32 * ib + r32], cib = rcum[32 * ib + r32];
#pragma unroll 1
        for (int jt = 0; jt < 4; ++jt) {
            f32x16 gt;
#pragma unroll
            for (int r = 0; r < 16; ++r) gt[r] = 0.f;
#pragma unroll
            for (int ks = 0; ks < 8; ++ks) gt = MFMA32(*(const bf16x8*)(BMp + (rb + 32 * jt + r32) * 256 + g * 128 + 16 * ks + 8 * hi), cfr[ks], gt);
            __builtin_amdgcn_sched_barrier(0);
#pragma unroll
            for (int r = 0; r < 16; ++r) {
                const int jl = crow16(r, hi), j = 32 * jt + jl;
                float fwd = 0.f, bwd = 0.f;
                if (jt < ib || (jt == ib && jl <= r32)) fwd = __expf(cif - cumf[j]) * dtf[j];
                if (jt > ib || (jt == ib && jl >= r32)) bwd = __expf(cib - rcum[j]) * dtb[j];
                gt[r] = gt[r] * (fwd + bwd);
            }
            __builtin_amdgcn_sched_barrier(0);
#pragma unroll
            for (int s = 0; s < 2; ++s) {
                v4u pa; pa.x = pk2(gt[8 * s], gt[8 * s + 1]); pa.y = pk2(gt[8 * s + 2], gt[8 * s + 3]); pa.z = pk2(gt[8 * s + 4], gt[8 * s + 5]); pa.w = pk2(gt[8 * s + 6], gt[8 * s + 7]);
                const bf16x8 afr = __builtin_bit_cast(bf16x8, pa);
#pragma unroll
                for (int pt = 0; pt < 2; ++pt) { const bf16* xp = XT + (size_t)(h * 64 + 32 * pt + r32) * MALL + rb + 32 * jt + 16 * s + 4 * hi;
                    const v2u lo = *(const v2u*)xp, hi4 = *(const v2u*)(xp + 8); v4u bb; bb.x = lo.x; bb.y = lo.y; bb.z = hi4.x; bb.w = hi4.y;
                    ya[pt] = MFMA32(afr, __builtin_bit_cast(bf16x8, bb), ya[pt]); }
            }
            __builtin_amdgcn_sched_barrier(0);
        }
        float rs[16];
#pragma unroll
        for (int r = 0; r < 16; ++r) rs[r] = 0.f;
#pragma unroll
        for (int pt = 0; pt < 2; ++pt) {
            const int ch = h * 64 + 32 * pt + r32;
#pragma unroll
            for (int q = 0; q < 4; ++q) { const v2u xv = *(const v2u*)(XT + (size_t)ch * MALL + rb + 32 * ib + 8 * q + 4 * hi);
                const float xs[4] = {bflo(xv.x), bfhi(xv.x), bflo(xv.y), bfhi(xv.y)};
#pragma unroll
                for (int e = 0; e < 4; ++e) { const int r = 4 * q + e; const float z = bf1(P2[(rb + 32 * ib + crow16(r, hi)) * P2W + 256 + ch]);
                    const float yv = (ya[pt][r] + dsk * xs[e]) * (z * sigm(z)); ya[pt][r] = yv; rs[r] += yv * yv; } }
            __builtin_amdgcn_sched_barrier(0);
        }
#pragma unroll
        for (int r = 0; r < 16; ++r) { float v = rs[r]; v += __shfl_xor(v, 1); v += __shfl_xor(v, 2); v += __shfl_xor(v, 4); v += __shfl_xor(v, 8); v += __shfl_xor(v, 16); rs[r] = v; }
        float* sq = ssqb + (ib & 1) * 256;
        if (r32 == 0) {
#pragma unroll
            for (int r = 0; r < 16; ++r) sq[h * 32 + crow16(r, hi)] = rs[r];
        }
        __syncthreads();
#pragma unroll
        for (int r = 0; r < 16; ++r) { const int il = crow16(r, hi); float tot = 0.f;
#pragma unroll
            for (int w = 0; w < 8; ++w) tot += sq[w * 32 + il];
            const float rstd = 1.0f / sqrtf(tot * (1.0f / 512.0f) + EPS);
            bf16* yo = Y + (rb + 32 * ib + il) * 1024 + 512 + h * 64 + r32;
            yo[0] = (bf16)f2bf(ya[0][r] * rstd * nw0); yo[32] = (bf16)f2bf(ya[1][r] * rstd * nw1); }
    }
    __syncthreads();
}
template <int NIB> __device__ __forceinline__ void ssd3_unit2(Frame& F, int l, int c, int i0) {
    F.fresh();
    const int lane = F.lane, tid = F.tid, h = F.wave, g = h >> 2, r32 = lane & 31, hi = lane >> 5;
    constexpr int PB = 264;
    bf16* Bs = (bf16*)F.lds; bf16* Cs = Bs + 128 * PB;
    float* tab = (float*)(F.lds + (128 + 64) * PB * 2) + h * 768;
    float* ssqb = (float*)(F.lds + (128 + 64) * PB * 2) + 8 * 768;
    const bf16* XT = (const bf16*)(F.wsp() + O_XT); const bf16* BMp = (const bf16*)(F.wsp() + O_BM); const bf16* CMp = (const bf16*)(F.wsp() + O_CM);
    const bf16* P2 = (const bf16*)(F.wsp() + O_P2); bf16* Y = (bf16*)(F.wsp() + O_Y);
    const float* DTF = (const float*)(F.wsp() + O_DTF); const float* DTB = (const float*)(F.wsp() + O_DTB);
    const bf16* S = (const bf16*)(F.wsp() + O_H);
    const size_t rb = (size_t)c * 128;
    {
        v4u tb[8], tc[2 * NIB];
#pragma unroll
        for (int q = 0; q < 8; ++q) { const int idx = tid + 512 * q; tb[q] = *(const v4u*)(BMp + (rb + (idx >> 5)) * 256 + (idx & 31) * 8); }
#pragma unroll
        for (int q = 0; q < 2 * NIB; ++q) { const int idx = tid + 512 * q; tc[q] = *(const v4u*)(CMp + (rb + i0 + (idx >> 5)) * 256 + (idx & 31) * 8); }
        const float Af = -expf(F.inp(17)[l * 8 + h]), Ab = -expf(F.inp(18)[l * 8 + h]);
        { const float d0 = DTF[(rb + 2 * lane) * 8 + h], d1 = DTF[(rb + 2 * lane + 1) * 8 + h]; const float a0 = d0 * Af, a1 = d1 * Af;
          const float inc = wave_incl_scan(a0 + a1, lane);
          tab[2 * lane] = inc - a1; tab[2 * lane + 1] = inc; tab[256 + 2 * lane] = d0; tab[256 + 2 * lane + 1] = d1;
          const float cend = __shfl(inc, 16 * (lane >> 4) + 15);
          tab[512 + 2 * lane] = __expf(cend - (inc - a1)) * d0; tab[512 + 2 * lane + 1] = __expf(cend - inc) * d1; }
        { const float d0 = DTB[(rb + 2 * lane) * 8 + h], d1 = DTB[(rb + 2 * lane + 1) * 8 + h]; const float a0 = d0 * Ab, a1 = d1 * Ab;
          const float inc = wave_incl_scan(a0 + a1, lane); const float tot = __shfl(inc, 63);
          tab[128 + 2 * lane] = tot - (inc - a0 - a1); tab[128 + 2 * lane + 1] = tot - (inc - a1); tab[384 + 2 * lane] = d0; tab[384 + 2 * lane + 1] = d1;
          const float estart = __shfl(inc - a0 - a1, 16 * (lane >> 4));
          tab[640 + 2 * lane] = __expf((inc - a0 - a1) - estart) * d0; tab[640 + 2 * lane + 1] = __expf((inc - a1) - estart) * d1; }
#pragma unroll
        for (int q = 0; q < 8; ++q) { const int idx = tid + 512 * q; *(v4u*)(Bs + (idx >> 5) * PB + (idx & 31) * 8) = tb[q]; }
#pragma unroll
        for (int q = 0; q < 2 * NIB; ++q) { const int idx = tid + 512 * q; *(v4u*)(Cs + (idx >> 5) * PB + (idx & 31) * 8) = tc[q]; }
    }
    __syncthreads();
    const float* cumf = tab; const float* rcum = tab + 128; const float* dtf = tab + 256; const float* dtb = tab + 384; const float* wjf = tab + 512; const float* wjb = tab + 640;
    const bf16* Hf = S + ((size_t)(0 * NCHUNK + c) * 8 + h) * 8192; const bf16* Hb = S + ((size_t)(1 * NCHUNK + c) * 8 + h) * 8192;
    const bf16* cbase = Cs + r32 * PB + g * 128 + 8 * hi;
    const bf16* bbase = Bs + r32 * PB + g * 128 + 8 * hi;
    f32x16 ya[NIB][2];
#pragma unroll
    for (int a = 0; a < NIB; ++a)
#pragma unroll
        for (int b = 0; b < 2; ++b)
#pragma unroll
            for (int r = 0; r < 16; ++r) ya[a][b][r] = 0.f;
#define SSD3_HLOAD(dst, Hp, pt_) do { _Pragma("unroll") for (int ks = 0; ks < 8; ++ks) dst[ks] = *(const bf16x8*)((Hp) + (size_t)(32 * (pt_) + r32) * 128 + 16 * ks + 8 * hi); } while (0)
#define SSD3_INTER(hq_, pt_, et_) do { _Pragma("unroll") for (int ib2 = 0; ib2 < NIB; ++ib2) { f32x16 t; _Pragma("unroll") for (int r = 0; r < 16; ++r) t[r] = 0.f; \
        _Pragma("unroll") for (int ks = 0; ks < 8; ++ks) t = MFMA32(*(const bf16x8*)(cbase + 32 * ib2 * PB + 16 * ks), hq_[ks], t); \
        _Pragma("unroll") for (int r = 0; r < 16; ++r) ya[ib2][pt_][r] += t[r] * __expf((et_)[i0 + 32 * ib2 + crow16(r, hi)]); } } while (0)
    {
        bf16x8 hq0[8], hq1[8];
        SSD3_HLOAD(hq0, Hf, 0);
#pragma unroll 1
        for (int dir = 0; dir < 2; ++dir) {
            const bf16* Hc = dir ? Hb : Hf; const float* et = dir ? rcum : cumf;
            SSD3_HLOAD(hq1, Hc, 1);
            SSD3_INTER(hq0, 0, et);
            SSD3_HLOAD(hq0, Hb, 0);
            SSD3_INTER(hq1, 1, et);
        }
    }
#define SSD3_ZLOAD(dst, ib2_) do { _Pragma("unroll") for (int pt = 0; pt < 2; ++pt) _Pragma("unroll") for (int r = 0; r < 16; ++r) dst[pt][r] = __builtin_nontemporal_load(P2 + (rb + i0 + 32 * (ib2_) + crow16(r, hi)) * P2W + 256 + h * 64 + 32 * pt + r32); } while (0)
    unsigned short zv0[2][16], zv1[2][16];
#define SSD3_XLOAD(dst, jt_) do { _Pragma("unroll") for (int s2 = 0; s2 < 2; ++s2) _Pragma("unroll") for (int pt = 0; pt < 2; ++pt) { \
        const bf16* xp = XT + (size_t)(h * 64 + 32 * pt + r32) * MALL + rb + 32 * (jt_) + 16 * s2 + 4 * hi; dst[s2][pt][0] = *(const v2u*)xp; dst[s2][pt][1] = *(const v2u*)(xp + 8); } } while (0)
#define SSD3_INTRA(xq_, jt_) do { _Pragma("unroll") for (int ib2 = 0; ib2 < NIB; ++ib2) { const int ib = (i0 >> 5) + ib2; f32x16 gt; _Pragma("unroll") for (int r = 0; r < 16; ++r) gt[r] = 0.f; \
        _Pragma("unroll") for (int ks = 0; ks < 8; ++ks) gt = MFMA32(*(const bf16x8*)(bbase + 32 * (jt_) * PB + 16 * ks), *(const bf16x8*)(cbase + 32 * ib2 * PB + 16 * ks), gt); \
        const float cif = cumf[32 * ib + r32], cib = rcum[32 * ib + r32]; \
        if ((jt_) < ib) { const float rf = __expf(cif - cumf[32 * (jt_) + 31]); _Pragma("unroll") for (int r = 0; r < 16; ++r) gt[r] *= rf * wjf[32 * (jt_) + crow16(r, hi)]; } \
        else if ((jt_) > ib) { const float rf = __expf(cib - rcum[32 * (jt_)]); _Pragma("unroll") for (int r = 0; r < 16; ++r) gt[r] *= rf * wjb[32 * (jt_) + crow16(r, hi)]; } \
        else { _Pragma("unroll") for (int r = 0; r < 16; ++r) { const int jl = crow16(r, hi), j = 32 * (jt_) + jl; \
            const float fwd = jl <= r32 ? __expf(cif - cumf[j]) * dtf[j] : 0.f, bwd = jl >= r32 ? __expf(cib - rcum[j]) * dtb[j] : 0.f; gt[r] *= (fwd + bwd); } } \
        _Pragma("unroll") for (int s2 = 0; s2 < 2; ++s2) { \
            v4u pa; pa.x = pk2(gt[8 * s2], gt[8 * s2 + 1]); pa.y = pk2(gt[8 * s2 + 2], gt[8 * s2 + 3]); pa.z = pk2(gt[8 * s2 + 4], gt[8 * s2 + 5]); pa.w = pk2(gt[8 * s2 + 6], gt[8 * s2 + 7]); \
            const bf16x8 afr = __builtin_bit_cast(bf16x8, pa); \
            _Pragma("unroll") for (int pt = 0; pt < 2; ++pt) { v4u bb; bb.x = xq_[s2][pt][0].x; bb.y = xq_[s2][pt][0].y; bb.z = xq_[s2][pt][1].x; bb.w = xq_[s2][pt][1].y; \
                ya[ib2][pt] = MFMA32(afr, __builtin_bit_cast(bf16x8, bb), ya[ib2][pt]); } } \
        __builtin_amdgcn_sched_barrier(0); } } while (0)
    {
        v2u xq0[2][2][2], xq1[2][2][2];
        SSD3_XLOAD(xq0, 0);
#pragma unroll 1
        for (int jp = 0; jp < 2; ++jp) {
            SSD3_XLOAD(xq1, 2 * jp + 1);
            SSD3_INTRA(xq0, 2 * jp);
            SSD3_XLOAD(xq0, (2 * jp + 2) & 3);
            SSD3_INTRA(xq1, 2 * jp + 1);
        }
    }
#undef SSD3_HLOAD
#undef SSD3_INTER
#undef SSD3_XLOAD
#undef SSD3_INTRA
    const float dsk = F.inp(19)[l * 8 + h];
    const float nw0 = F.inp(20)[l * 512 + h * 64 + r32], nw1 = F.inp(20)[l * 512 + h * 64 + 32 + r32];
#define SSD3_EPI(ib2, zv_) do { float rs[16]; _Pragma("unroll") for (int r = 0; r < 16; ++r) rs[r] = 0.f; \
        _Pragma("unroll") for (int pt = 0; pt < 2; ++pt) { const int ch = h * 64 + 32 * pt + r32; \
            _Pragma("unroll") for (int q = 0; q < 4; ++q) { const v2u xv = *(const v2u*)(XT + (size_t)ch * MALL + rb + i0 + 32 * (ib2) + 8 * q + 4 * hi); \
                const float xs[4] = {bflo(xv.x), bfhi(xv.x), bflo(xv.y), bfhi(xv.y)}; \
                _Pragma("unroll") for (int e = 0; e < 4; ++e) { const int r = 4 * q + e; const float z = bf1(zv_[pt][r]); \
                    const float yv = (ya[ib2][pt][r] + dsk * xs[e]) * (z * sigm(z)); ya[ib2][pt][r] = yv; rs[r] += yv * yv; } } } \
        _Pragma("unroll") for (int r = 0; r < 16; ++r) { float v = dpp_sum16_all(rs[r]); v += __shfl_xor(v, 16); rs[r] = v; } \
        float* sq = ssqb + (ib2) * 256; \
        if (r32 == 0) { _Pragma("unroll") for (int r = 0; r < 16; ++r) sq[h * 32 + crow16(r, hi)] = rs[r]; } \
        __syncthreads(); \
        _Pragma("unroll") for (int r = 0; r < 16; ++r) { const int il = crow16(r, hi); float tot = 0.f; \
            _Pragma("unroll") for (int w = 0; w < 8; ++w) tot += sq[w * 32 + il]; \
            const float rstd = 1.0f / sqrtf(tot * (1.0f / 512.0f) + EPS); \
            bf16* yo = Y + (rb + i0 + 32 * (ib2) + il) * 1024 + 512 + h * 64 + r32; \
            yo[0] = (bf16)f2bf(ya[ib2][0][r] * rstd * nw0); yo[32] = (bf16)f2bf(ya[ib2][1][r] * rstd * nw1); } \
        __builtin_amdgcn_sched_barrier(0); } while (0)
    SSD3_ZLOAD(zv0, 0);
    SSD3_EPI(0, zv0);
    if constexpr (NIB == 2) { SSD3_ZLOAD(zv1, 1); SSD3_EPI(1, zv1); }
#undef SSD3_EPI
#undef SSD3_ZLOAD
    __syncthreads();
}
__device__ __forceinline__ void phase_mix(Frame& F, int l) {
    using abf = attn_body::bf16;
    const abf* Yq = (const abf*)(F.wsp() + O_Y); const abf* KN = (const abf*)(F.wsp() + O_KN); const abf* VN = (const abf*)(F.wsp() + O_VN);
    for (int rp_ = 0; rp_ < ((REPM & 64) ? 2 : 1); ++rp_) {
        for (int u = F.bid; u < 256; u += F.G) ssd3_unit2<2>(F, l, u >> 1, (u & 1) * 64);
        if (l == 0) for (int q = (F.bid + F.G - 64 % F.G) % F.G; q < 64; q += F.G) ssd3_unit2<1>(F, l, 128 + (q >> 2), (q & 3) * 32);
    }
    __syncthreads();
    if (REPM & 1024) for (int u = F.bid; u < 512; u += F.G) {
        const int b = u >> 6, hq = (u >> 3) & 7, qb = u & 7; const size_t qrow = (size_t)b * SEQ + qb * 256;
        attn_body::attn_unit<8, P2W>(Yq + qrow * 1024 + hq * 64, KN + (size_t)b * KVLEN * 128 + (hq >> 2) * 64, VN + (size_t)b * KVLEN * 128 + (hq >> 2) * 64, (abf*)(F.wsp() + O_P2) + qrow * P2W + 768 + hq * 64, KVLEN / 64, (char*)F.lds);
    }
    const int vcu = (F.G % 8 == 0) ? (F.bid & 7) * (F.G >> 3) + (F.bid >> 3) : F.bid;
    for (int u = vcu; u < 512; u += F.G) {
        const int b = u >> 6, hq = (u >> 3) & 7, qb = u & 7; const size_t qrow = (size_t)b * SEQ + qb * 256;
        attn_body::attn_unit<8>(Yq + qrow * 1024 + hq * 64, KN + (size_t)b * KVLEN * 128 + (hq >> 2) * 64, VN + (size_t)b * KVLEN * 128 + (hq >> 2) * 64, (abf*)Yq + qrow * 1024 + hq * 64, KVLEN / 64, (char*)F.lds);
    }
    if (l == 0) {
        for (int u = F.bid; u < 64; u += F.G) {
            const int b = u >> 3, hq = u & 7; const size_t qrow = (size_t)NLAT + b * CTXL;
            attn_body::attn_unit<8>(Yq + qrow * 1024 + hq * 64, KN + (size_t)b * KVLEN * 128 + (hq >> 2) * 64, VN + (size_t)b * KVLEN * 128 + (hq >> 2) * 64, (abf*)Yq + qrow * 1024 + hq * 64, CTXL / 64, (char*)F.lds);
        }
    }
}
template <int GC> __global__ void __launch_bounds__(NWAVES * 64, 2) hybrid_fwd(Args args) {
    extern __shared__ __attribute__((aligned(16))) unsigned char lds[];
    cg::grid_group grid = cg::this_grid();
    volatile LAS unsigned* bst = (volatile LAS unsigned*)((LAS unsigned char*)lds + RING_BYTES + 320);
    if (threadIdx.x < 2) bst[threadIdx.x] = 0u;
    __syncthreads();
    (void)xcd_barrier_post((unsigned*)args.ws, bst);
    Frame F;
    F.lds = lds; F.tid = threadIdx.x; F.lane = F.tid & 63; F.wave = __builtin_amdgcn_readfirstlane(F.tid >> 6); F.G = GC ? GC : (int)gridDim.x; F.bid = blockIdx.x;
    F.ap = (kargp_t)__builtin_amdgcn_kernarg_segment_ptr();
    F.out = args.out; F.ws = args.ws;
    PG8_LAS unsigned char* ldsg = (PG8_LAS unsigned char*)lds;
    pg8::bf16_t* Hb = (pg8::bf16_t*)(F.wsp() + O_H);

#define GSYNC() do { XcdBarrier b_; b_.bar = (unsigned*)F.wsp(); b_.x = xb_xcc_id(); b_.st = bst; xcd_barrier(b_); if (REPM & 1) xcd_barrier(b_); } while (0)
    for (int rp_ = 0; rp_ < ((REPM & 128) ? 2 : 1); ++rp_) if (PHM & 1) phase_prologue(F);
    if (args.ws == nullptr) grid.sync();
    GSYNC();
    for (int rp_ = 0; rp_ < ((REPM & 512) ? 2 : 1); ++rp_) if (PHM & 2) phase_rows<false, true, true>(F, 0, MALL, 0, F.G, true, 0, 0, 0, 0, 0, 6);
    GSYNC();
#ifndef LUNROLL
#define LUNROLL 2
#endif
#pragma unroll LUNROLL
    for (int l = 0; l < DEPTH; ++l) {
        const pg8::bf16_t* wl = (const pg8::bf16_t*)(F.wsp() + O_W + (size_t)l * WL_SIZE);
        const int mrows = l == 0 ? MALL : NLAT;
        for (int rp_ = 0; rp_ < ((REPM & 2) ? 2 : 1); ++rp_) if (PHM & 4) {
            pg8::Gemm g{Hb, wl + WL_IN / 2, MALL, NIN, 1024}; pg8::StaticOrder S; S.init(MALL, NIN, F.G, F.bid);
            pg8::EpiStoreBf16 E{(pg8::bf16_t*)(F.wsp() + O_Y), 1024, (pg8::bf16_t*)(F.wsp() + O_P2), P2W, 2};
            pg8::gemm_phase<pg8::EpiStoreBf16, pg8::StaticOrder, PG8_ALIGN, PG8_SP2>(ldsg, g, S, E);
        }
        GSYNC();
        if (PHM & 8) phase_post(F, l);
        GSYNC();
#ifndef SSD12
#define SSD12 0
#endif
        if (SSD12) { for (int rp_ = 0; rp_ < ((REPM & 32) ? 2 : 1); ++rp_) phase_ssd12(F, l); }
        else { phase_ssd1(F, l); GSYNC(); phase_ssd2(F); }
        GSYNC();
        if (PHM & 64) phase_mix(F, l);
        GSYNC();
        const int nparts = l == 0 ? 2 : 1;
        for (int part = 0; part < nparts; ++part) {
            const bool cx = part == 1; const size_t roff = cx ? (size_t)NLAT * 1024 : 0;
            if (!cx || F.bid < 32) {
                pg8::Gemm g{(const pg8::bf16_t*)(F.wsp() + O_Y) + roff, wl + WL_OUT / 2, cx ? NCTX : NLAT, 1024, 1024}; pg8::StaticOrder S; S.init(cx ? NCTX : NLAT, 1024, cx ? 32 : F.G, F.bid);
                pg8::EpiStoreBf16 E{Hb + roff, 1024, Hb + roff, 1024, 1 << 20};
                pg8::gemm_phase<pg8::EpiStoreBf16, pg8::StaticOrder, PG8_ALIGN, PG8_SP2>(ldsg, g, S, E);
            }
            if (cx) phase_rows<true, true, false>(F, 0, NLAT, 32, F.G - 32, true, l, 2, 7, l, 3, 8);
            GSYNC();
        }
        phase_rows<true, true, false>(F, l == 0 ? NLAT : 0, l == 0 ? MALL : NLAT, 0, F.G, l == 0, l, 2, 7, l, 3, 8);
        GSYNC();
        for (int rp_ = 0; rp_ < ((REPM & 8) ? 2 : 1); ++rp_) if (PHM & 512) {
            pg8::Gemm g{Hb, wl + WL_GU / 2, mrows, 2 * DFF, 1024}; pg8::StaticOrder S; S.init(mrows, 2 * DFF, F.G, F.bid);
            pg8::EpiSwiGLU E{(pg8::bf16_t*)(F.wsp() + O_ACT), DFF};
            pg8::gemm_phase<pg8::EpiSwiGLU, pg8::StaticOrder, PG8_ALIGN, PG8_SP2>(ldsg, g, S, E);
        }
        GSYNC();
        for (int part = 0; part < nparts; ++part) {
            const bool cx = part == 1; const size_t roff = cx ? (size_t)NLAT : 0;
            if (l + 1 == DEPTH && F.G == 256) {
                pg8::Gemm g{(const pg8::bf16_t*)(F.wsp() + O_ACT), wl + WL_D / 2, NLAT, 1024, DFF}; pg8::StaticOrder S; S.init(NLAT, 1024, F.G, F.bid);
                pg8::Unit u0; S.next(0, u0);
                pg8::EpiRmsRes E{F.outp(), F.outp(), 1024, (const float*)(F.wsp() + O_MOD) + ((size_t)l * 9 + (u0.pm >> 3)) * 6144 + 5 * 1024, F.inp(9) + (size_t)l * 1024,
                                 (float*)(F.wsp() + O_XS), (unsigned*)(F.wsp() + CTL_PANEL), EPS};
                pg8::gemm_phase<pg8::EpiRmsRes, pg8::StaticOrder, false, PG8_SP2>(ldsg, g, S, E);
            } else
            if (!cx || F.bid < 32) {
                pg8::Gemm g{(const pg8::bf16_t*)(F.wsp() + O_ACT) + roff * DFF, wl + WL_D / 2, cx ? NCTX : NLAT, 1024, DFF}; pg8::StaticOrder S; S.init(cx ? NCTX : NLAT, 1024, cx ? 32 : F.G, F.bid);
                pg8::EpiStoreBf16 E{Hb + roff * 1024, 1024, Hb + roff * 1024, 1024, 1 << 20};
                pg8::gemm_phase<pg8::EpiStoreBf16, pg8::StaticOrder, PG8_ALIGN, PG8_SP2>(ldsg, g, S, E);
            }
            if (cx) phase_rows<true, true, true>(F, 0, NLAT, 32, F.G - 32, false, l, 5, 9, l + 1, 0, 6);
            if (!(l + 1 == DEPTH && F.G == 256)) GSYNC();
        }
        if (l + 1 < DEPTH) { phase_rows<true, true, true>(F, NLAT, MALL, 0, F.G, false, l, 5, 9, l + 1, 0, 6); GSYNC(); }
        else if (F.G != 256) phase_rows<true, false, false>(F, 0, NLAT, 0, F.G, false, l, 5, 9, 0, 0, 0);
    }
}
extern "C" void kernel_launch(void* const* d_in, const int* in_sizes, int n_in, void* d_out, int out_size, void* d_ws, size_t ws_size, hipStream_t stream) {
    static int grid = 0; static const void* kfn = (const void*)hybrid_fwd<0>;
    if (grid == 0) {
        if (n_in != 25 || in_sizes[0] != NLAT * 1024 || out_size != NLAT * 1024 || ws_size < O_END2) { fprintf(stderr, "kernel_launch: unexpected problem (n_in %d, ws %zu, need %zu)\n", n_in, ws_size, (size_t)O_END2); grid = -1; return; }
        int dev = 0, cus = 0, per_cu = 0;
        hipGetDevice(&dev); hipDeviceGetAttribute(&cus, hipDeviceAttributeMultiprocessorCount, dev);
        if (hipFuncSetAttribute(kfn, hipFuncAttributeMaxDynamicSharedMemorySize, LDS_BYTES) != hipSuccess) { fprintf(stderr, "kernel_launch: hipFuncSetAttribute failed\n"); grid = -1; return; }
        if (hipOccupancyMaxActiveBlocksPerMultiprocessor(&per_cu, kfn, NWAVES * 64, LDS_BYTES) != hipSuccess || per_cu < 1) { fprintf(stderr, "kernel_launch: occupancy query gave %d\n", per_cu); per_cu = 1; }
        (void)hipGetLastError();
        grid = cus * per_cu;
        if (grid == 256) { kfn = (const void*)hybrid_fwd<256>;
            if (hipFuncSetAttribute(kfn, hipFuncAttributeMaxDynamicSharedMemorySize, LDS_BYTES) != hipSuccess) { fprintf(stderr, "kernel_launch: hipFuncSetAttribute failed\n"); grid = -1; return; } }
        fprintf(stderr, "kernel_launch: grid %d (cus %d x %d)\n", grid, cus, per_cu);
    }
    if (grid < 0) return;
    if (hipMemsetAsync(d_ws, 0, CTL_BYTES, stream) != hipSuccess) { fprintf(stderr, "kernel_launch: memset failed\n"); return; }
    Args a{};
    for (int i = 0; i < 25; ++i) a.in[i] = (const float*)d_in[i];
    a.out = (float*)d_out; a.ws = (unsigned char*)d_ws;
    void* kargs[] = {&a};
    const hipError_t e = hipLaunchCooperativeKernel(kfn, dim3(grid), dim3(NWAVES * 64), kargs, LDS_BYTES, stream);
    if (e != hipSuccess) fprintf(stderr, "kernel_launch: cooperative launch failed: %s (grid %d)\n", hipGetErrorString(e), grid);
}
```
